# Optimizing an MI355X kernel written in HIP

```python
import jax, jax.numpy as jnp
from jax import lax
import numpy as np

D_MODEL = 1024
BATCH = 4
SEQ = 8192
DEPTH = 2

HEAD_DIM = 64
N_HEADS = 4
BRANCH_WIDTH = N_HEADS * HEAD_DIM
N_BRANCHES = 4
Q_BLOCK = 128
RMS_EPS = 1e-6

DSW_PATTERNS = ((128, 1), (512, 4), (2048, 16))

MLA_Q_RANK = 192
MLA_KV_RANK = 128
MLA_NOPE_DIM = 64
MLA_ROPE_DIM = 32
MLA_V_DIM = 64
ROPE_THETA = 10000.0

NSA_CMP_BLOCK = 32
NSA_CMP_STRIDE = 16
NSA_CMP_HIDDEN = 128
NSA_SEL_BLOCK = 64
NSA_TOP_N = 16
NSA_WINDOW = 512
NSA_KV_DIM = 64
NSA_FORCE_SCORE = 1e9

N_ALIBI_HEADS = 8

IN_SPLITS = (
    ("a_q", BRANCH_WIDTH), ("a_k", BRANCH_WIDTH), ("a_v", BRANCH_WIDTH), ("a_gate", BRANCH_WIDTH),
    ("b_cq", MLA_Q_RANK), ("b_ckv", MLA_KV_RANK), ("b_kpe", MLA_ROPE_DIM), ("b_gate", BRANCH_WIDTH),
    ("c_q", BRANCH_WIDTH), ("c_kc", NSA_KV_DIM), ("c_vc", NSA_KV_DIM), ("c_ks", NSA_KV_DIM),
    ("c_vs", NSA_KV_DIM), ("c_kw", NSA_KV_DIM), ("c_vw", NSA_KV_DIM), ("c_g", 3 * N_HEADS),
    ("c_gate", BRANCH_WIDTH),
    ("d_q", BRANCH_WIDTH), ("d_k", BRANCH_WIDTH), ("d_v", BRANCH_WIDTH), ("d_gate", BRANCH_WIDTH),
)
D_IN = sum(w for _, w in IN_SPLITS)

kernel_name = "hybrid_gated_dilated_mla_nsa_stickbreaking"


def rmsnorm(x, g):
    xf = x.astype(jnp.float32)
    y = xf * lax.rsqrt(jnp.mean(xf * xf, axis=-1, keepdims=True) + RMS_EPS)
    return (y * g.astype(jnp.float32)).astype(x.dtype)


def split_columns(p):
    out, off = {}, 0
    for name, w in IN_SPLITS:
        out[name] = p[..., off:off + w]
        off += w
    return out


def alibi_slopes():
    s = 2.0 ** (-8.0 * (np.arange(N_ALIBI_HEADS) + 1) / N_ALIBI_HEADS)
    s = jnp.asarray(s, jnp.float32)
    return s[0::2], s[1::2]


def masked_softmax(s, mask):
    s = jnp.where(mask, s, -jnp.inf)
    m = jnp.max(s, axis=-1, keepdims=True)
    m = jnp.where(jnp.isfinite(m), m, 0.0)
    e = jnp.exp(s - m)
    return e / jnp.maximum(jnp.sum(e, axis=-1, keepdims=True), 1e-30)


def sweep_query_blocks(block_fn, seq):
    out = lax.map(block_fn, jnp.arange(seq // Q_BLOCK))
    nq, b, tq, h, d = out.shape
    return jnp.swapaxes(out, 0, 1).reshape(b, nq * tq, h, d)


def rope(x, pos):
    half = x.shape[-1] // 2
    inv = ROPE_THETA ** (-jnp.arange(half, dtype=jnp.float32) / half)
    ang = pos.astype(jnp.float32)[:, None] * inv[None, :]
    cos, sin = jnp.cos(ang)[:, None, :], jnp.sin(ang)[:, None, :]
    xf = x.astype(jnp.float32)
    x1, x2 = xf[..., :half], xf[..., half:]
    return jnp.concatenate([x1 * cos - x2 * sin, x1 * sin + x2 * cos], axis=-1).astype(x.dtype)


def dilated_window_attention(q, k, v, slopes):
    B, S, H, Dh = q.shape
    scale = Dh ** -0.5

    def block(qb):
        t0 = qb * Q_BLOCK
        t = t0 + jnp.arange(Q_BLOCK)
        qblk = lax.dynamic_slice_in_dim(q, t0, Q_BLOCK, axis=1)
        outs, lses = [], []
        for window, dil in DSW_PATTERNS:
            dist = dil * jnp.arange(window // dil + 1)
            idx = t[:, None] - dist[None, :]
            valid = idx >= 0
            idxc = jnp.maximum(idx, 0)
            kg, vg = k[:, idxc], v[:, idxc]
            s = jnp.einsum('bqhd,bqjhd->bhqj', qblk, kg).astype(jnp.float32) * scale
            s = s - slopes[:, None, None] * dist.astype(jnp.float32)
            s = jnp.where(valid[None, None], s, -jnp.inf)
            lse = jax.nn.logsumexp(s, axis=-1)
            p = jnp.exp(s - lse[..., None])
            outs.append(jnp.einsum('bhqj,bqjhd->bqhd', p.astype(v.dtype), vg))
            lses.append(lse)
        w = jax.nn.softmax(jnp.stack(lses, axis=0), axis=0)
        o = 0.0
        for i in range(len(DSW_PATTERNS)):
            o = o + jnp.transpose(w[i], (0, 2, 1))[..., None].astype(v.dtype) * outs[i]
        return o

    return sweep_query_blocks(block, S)


def blocked_causal_softmax(q, k, v, scale):
    B, S, H, _ = q.shape
    kpos = jnp.arange(S)

    def block(qb):
        t0 = qb * Q_BLOCK
        t = t0 + jnp.arange(Q_BLOCK)
        qblk = lax.dynamic_slice_in_dim(q, t0, Q_BLOCK, axis=1)
        s = jnp.einsum('bqhd,bkhd->bhqk', qblk, k).astype(jnp.float32) * scale
        s = jnp.where(kpos[None, :] <= t[:, None], s, -jnp.inf)
        p = jax.nn.softmax(s, axis=-1)
        return jnp.einsum('bhqk,bkhd->bqhd', p.astype(v.dtype), v)

    return sweep_query_blocks(block, S)


def mla_attention(cq, ckv, kpe, q_norm_g, w_uq, kv_norm_g, w_ukv):
    B, S, _ = cq.shape
    pos = jnp.arange(S)
    q = (rmsnorm(cq, q_norm_g) @ w_uq).reshape(B, S, N_HEADS, MLA_NOPE_DIM + MLA_ROPE_DIM)
    q = jnp.concatenate([q[..., :MLA_NOPE_DIM], rope(q[..., MLA_NOPE_DIM:], pos)], axis=-1)
    kv = (rmsnorm(ckv, kv_norm_g) @ w_ukv).reshape(B, S, N_HEADS, MLA_NOPE_DIM + MLA_V_DIM)
    k_nope, v = kv[..., :MLA_NOPE_DIM], kv[..., MLA_NOPE_DIM:]
    k_pe = rope(kpe[:, :, None, :], pos)
    k = jnp.concatenate([k_nope, jnp.broadcast_to(k_pe, (B, S, N_HEADS, MLA_ROPE_DIM))], axis=-1)
    return blocked_causal_softmax(q, k, v, (MLA_NOPE_DIM + MLA_ROPE_DIM) ** -0.5)


def compress_blocks(tok, pos_emb, w1, b1, w2, b2):
    B, S, Dk = tok.shape
    n_cmp = (S - NSA_CMP_BLOCK) // NSA_CMP_STRIDE + 1
    idx = np.arange(n_cmp)[:, None] * NSA_CMP_STRIDE + np.arange(NSA_CMP_BLOCK)[None, :]
    blocks = tok[:, idx] + pos_emb
    hid = jax.nn.gelu(blocks.reshape(B, n_cmp, NSA_CMP_BLOCK * Dk) @ w1 + b1)
    return hid @ w2 + b2


def nsa_attention(q, kc, vc, ks, vs, kw, vw, gates, pos_emb, w1, b1, w2, b2, slopes):
    B, S, H, Dh = q.shape
    scale = Dh ** -0.5
    k_cmp = compress_blocks(kc, pos_emb[0], w1[0], b1[0], w2[0], b2[0])
    v_cmp = compress_blocks(vc, pos_emb[1], w1[1], b1[1], w2[1], b2[1])
    n_cmp = k_cmp.shape[1]
    cmp_end = jnp.arange(n_cmp) * NSA_CMP_STRIDE + NSA_CMP_BLOCK - 1
    n_sel = S // NSA_SEL_BLOCK
    top_n = min(NSA_TOP_N, n_sel)
    r_sel, r_cmp = NSA_SEL_BLOCK // NSA_CMP_STRIDE, NSA_CMP_BLOCK // NSA_CMP_STRIDE
    src = (jnp.arange(n_sel)[:, None, None] * r_sel - jnp.arange(r_sel)[None, :, None]
           - jnp.arange(r_cmp)[None, None, :]).reshape(n_sel, -1)
    sel_map = jnp.sum(src[..., None] == jnp.arange(n_cmp), axis=1).astype(jnp.float32)
    kw_pad = jnp.pad(kw, ((0, 0), (NSA_WINDOW, 0), (0, 0)))
    vw_pad = jnp.pad(vw, ((0, 0), (NSA_WINDOW, 0), (0, 0)))
    blk = jnp.arange(n_sel)
    sel_off = jnp.arange(NSA_SEL_BLOCK)

    def block(qb):
        t0 = qb * Q_BLOCK
        t = t0 + jnp.arange(Q_BLOCK)
        qblk = lax.dynamic_slice_in_dim(q, t0, Q_BLOCK, axis=1)
        gblk = lax.dynamic_slice_in_dim(gates, t0, Q_BLOCK, axis=1)
        dist_c = (t[:, None] - cmp_end[None, :]).astype(jnp.float32)
        s = jnp.einsum('bqhd,bnd->bhqn', qblk, k_cmp).astype(jnp.float32) * scale
        p_cmp = masked_softmax(s - slopes[:, None, None] * dist_c, dist_c >= 0)
        o_cmp = jnp.einsum('bhqn,bnd->bqhd', p_cmp.astype(v_cmp.dtype), v_cmp)
        p_sel = jnp.einsum('bhqn,jn->bqj', p_cmp, sel_map)
        cur = t // NSA_SEL_BLOCK
        valid = blk[None, :] * NSA_SEL_BLOCK <= t[:, None]
        forced = (blk[None, :] == 0) | (blk[None, :] == cur[:, None]) | (blk[None, :] == cur[:, None] - 1)
        score = jnp.where(valid, jnp.where(forced, NSA_FORCE_SCORE, p_sel), -jnp.inf)
        _, sel = lax.top_k(score, top_n)
        tok = (sel[..., None] * NSA_SEL_BLOCK + sel_off).reshape(B, Q_BLOCK, top_n * NSA_SEL_BLOCK)
        ks_g = jax.vmap(lambda a, i: a[i])(ks, tok)
        vs_g = jax.vmap(lambda a, i: a[i])(vs, tok)
        dist_s = (t[None, :, None] - tok).astype(jnp.float32)
        s = jnp.einsum('bqhd,bqkd->bhqk', qblk, ks_g).astype(jnp.float32) * scale
        s = s - slopes[None, :, None, None] * dist_s[:, None]
        p = masked_softmax(s, (dist_s >= 0)[:, None])
        o_slc = jnp.einsum('bhqk,bqkd->bqhd', p.astype(vs_g.dtype), vs_g)
        kwin = lax.dynamic_slice_in_dim(kw_pad, t0, Q_BLOCK + NSA_WINDOW, axis=1)
        vwin = lax.dynamic_slice_in_dim(vw_pad, t0, Q_BLOCK + NSA_WINDOW, axis=1)
        spos = t0 - NSA_WINDOW + jnp.arange(Q_BLOCK + NSA_WINDOW)
        dist_w = t[:, None] - spos[None, :]
        mask_w = (dist_w >= 0) & (dist_w < NSA_WINDOW) & (spos[None, :] >= 0)
        s = jnp.einsum('bqhd,bkd->bhqk', qblk, kwin).astype(jnp.float32) * scale
        p = masked_softmax(s - slopes[:, None, None] * dist_w.astype(jnp.float32), mask_w)
        o_win = jnp.einsum('bhqk,bkd->bqhd', p.astype(vwin.dtype), vwin)
        return gblk[..., 0:1] * o_cmp + gblk[..., 1:2] * o_slc + gblk[..., 2:3] * o_win

    return sweep_query_blocks(block, S)


def stick_breaking_attention(q, k, v):
    B, S, H, Dh = q.shape
    scale = Dh ** -0.5
    kpos = jnp.arange(S)

    def block(qb):
        t0 = qb * Q_BLOCK
        t = t0 + jnp.arange(Q_BLOCK)
        qblk = lax.dynamic_slice_in_dim(q, t0, Q_BLOCK, axis=1)
        z = jnp.einsum('bqhd,bkhd->bhqk', qblk, k).astype(jnp.float32) * scale
        mask = kpos[None, :] < t[:, None]
        log1m = jnp.where(mask, jax.nn.log_sigmoid(-z), 0.0)
        after = lax.cumsum(log1m, axis=3, reverse=True) - log1m
        a = jnp.where(mask, jnp.exp(jax.nn.log_sigmoid(z) + after), 0.0)
        return jnp.einsum('bhqk,bkhd->bqhd', a.astype(v.dtype), v)

    return sweep_query_blocks(block, S)


def setup_inputs(seed: int = 0) -> dict:
    key = jax.random.key(seed)
    ks = jax.random.split(key, 18)
    f32 = jnp.float32

    def nrm(k, shape, fan_in):
        return jax.random.normal(k, shape, f32) * (fan_in ** -0.5)

    def gain(k, shape):
        return 1.0 + 0.05 * jax.random.normal(k, shape, f32)

    return {
        "x": jax.random.normal(ks[0], (BATCH, SEQ, D_MODEL), f32),
        "norm_g": gain(ks[1], (DEPTH, D_MODEL)),
        "w_in": nrm(ks[2], (DEPTH, D_MODEL, D_IN), D_MODEL),
        "mla_q_norm": gain(ks[3], (DEPTH, MLA_Q_RANK)),
        "mla_w_uq": nrm(ks[4], (DEPTH, MLA_Q_RANK, N_HEADS * (MLA_NOPE_DIM + MLA_ROPE_DIM)), MLA_Q_RANK),
        "mla_kv_norm": gain(ks[5], (DEPTH, MLA_KV_RANK)),
        "mla_w_ukv": nrm(ks[6], (DEPTH, MLA_KV_RANK, N_HEADS * (MLA_NOPE_DIM + MLA_V_DIM)), MLA_KV_RANK),
        "nsa_pos": 0.1 * jax.random.normal(ks[7], (DEPTH, 2, NSA_CMP_BLOCK, NSA_KV_DIM), f32),
        "nsa_w1": nrm(ks[8], (DEPTH, 2, NSA_CMP_BLOCK * NSA_KV_DIM, NSA_CMP_HIDDEN), NSA_CMP_BLOCK * NSA_KV_DIM),
        "nsa_b1": 0.02 * jax.random.normal(ks[9], (DEPTH, 2, NSA_CMP_HIDDEN), f32),
        "nsa_w2": nrm(ks[10], (DEPTH, 2, NSA_CMP_HIDDEN, NSA_KV_DIM), NSA_CMP_HIDDEN),
        "nsa_b2": 0.02 * jax.random.normal(ks[11], (DEPTH, 2, NSA_KV_DIM), f32),
        "w_branch": nrm(ks[12], (DEPTH, N_BRANCHES, BRANCH_WIDTH, D_MODEL), BRANCH_WIDTH),
        "w_merge": nrm(ks[13], (DEPTH, N_BRANCHES, D_MODEL, D_MODEL), D_MODEL),
        "b_merge": 0.02 * jax.random.normal(ks[14], (DEPTH, N_BRANCHES, D_MODEL), f32),
        "w_out": nrm(ks[15], (DEPTH, D_MODEL, D_MODEL), D_MODEL),
        "final_norm_g": gain(ks[16], (D_MODEL,)),
    }


def reference(x, norm_g, w_in, mla_q_norm, mla_w_uq, mla_kv_norm, mla_w_ukv, nsa_pos, nsa_w1,
              nsa_b1, nsa_w2, nsa_b2, w_branch, w_merge, b_merge, w_out, final_norm_g):
    B, S, D = x.shape
    slopes_a, slopes_c = alibi_slopes()
    for l in range(DEPTH):
        h = rmsnorm(x, norm_g[l])
        c = split_columns(h @ w_in[l])
        heads = lambda a: a.reshape(B, S, N_HEADS, HEAD_DIM)
        flat = lambda a: a.reshape(B, S, BRANCH_WIDTH)
        y_a = flat(dilated_window_attention(heads(c["a_q"]), heads(c["a_k"]), heads(c["a_v"]), slopes_a))
        y_a = y_a * jax.nn.silu(c["a_gate"])
        y_b = flat(mla_attention(c["b_cq"], c["b_ckv"], c["b_kpe"], mla_q_norm[l], mla_w_uq[l],
                                 mla_kv_norm[l], mla_w_ukv[l]))
        y_b = y_b * jax.nn.silu(c["b_gate"])
        g_c = jax.nn.sigmoid(c["c_g"]).reshape(B, S, N_HEADS, 3)
        y_c = flat(nsa_attention(heads(c["c_q"]), c["c_kc"], c["c_vc"], c["c_ks"], c["c_vs"],
                                 c["c_kw"], c["c_vw"], g_c, nsa_pos[l], nsa_w1[l], nsa_b1[l],
                                 nsa_w2[l], nsa_b2[l], slopes_c))
        y_c = y_c * jax.nn.silu(c["c_gate"])
        y_d = flat(stick_breaking_attention(heads(c["d_q"]), heads(c["d_k"]), heads(c["d_v"])))
        y_d = y_d * jax.nn.silu(c["d_gate"])
        merged = 0.0
        for i, y in enumerate((y_a, y_b, y_c, y_d)):
            gate = jax.nn.sigmoid(h @ w_merge[l, i] + b_merge[l, i])
            merged = merged + gate * (y @ w_branch[l, i])
        x = x + merged @ w_out[l]
    return rmsnorm(x, final_norm_g)
```

```cpp
#include <hip/hip_runtime.h>
#include <hip/hip_cooperative_groups.h>
#include <cstdio>
#include <cstdint>
namespace cg = cooperative_groups;

#define LAS __attribute__((address_space(3)))
#define DEV __device__ __forceinline__
typedef unsigned short bf16_t;
typedef short bf16x8 __attribute__((ext_vector_type(8)));
typedef short s16x4 __attribute__((ext_vector_type(4)));
typedef float f32x2 __attribute__((ext_vector_type(2)));
typedef float f32x4 __attribute__((ext_vector_type(4)));
typedef float f32x16 __attribute__((ext_vector_type(16)));
typedef unsigned u32x2 __attribute__((ext_vector_type(2)));
typedef unsigned u32x4 __attribute__((ext_vector_type(4)));

constexpr int NB = 4, S = 8192, T = NB * S, DM = 1024, CP = 3584;
constexpr int A_Q = 0, A_K = 256, A_V = 512, A_G = 768, B_G = 1024, C_Q = 1280, C_G = 1536, D_Q = 1792, D_K = 2048, D_V = 2304, D_G = 2560,
              B_CQ = 2816, B_CKV = 3008, B_KPE = 3136, C_KC = 3168, C_VC = 3232, C_KS = 3296, C_VS = 3360, C_KW = 3424, C_VW = 3488, C_GT = 3552;
constexpr float LOG2E = 1.44269504088896f;
constexpr float NEG = -1e30f;

constexpr size_t W_IN = 0, W_MG = W_IN + (size_t)CP * 1024 * 2, W_BR = W_MG + (size_t)4096 * 1024 * 2, W_OUT = W_BR + (size_t)4096 * 256 * 2,
                 W_UQ = W_OUT + (size_t)1024 * 1024 * 2, W_UKV = W_UQ + (size_t)384 * 192 * 2, W_W1 = W_UKV + (size_t)512 * 128 * 2,
                 W_W2 = W_W1 + (size_t)2 * 128 * 2048 * 2, W_LAYER = W_W2 + (size_t)2 * 64 * 128 * 2;
constexpr size_t WS_H = 2 * W_LAYER, WS_C = WS_H + (size_t)T * 1024 * 2, WS_R = WS_C + (size_t)T * CP * 2;
constexpr size_t R_QB = WS_R, R_KB = R_QB + (size_t)T * 384 * 2, R_VTB = R_KB + (size_t)T * 384 * 2, R_VTD = R_VTB + (size_t)T * 256 * 2,
                 R_VTA1 = R_VTD + (size_t)T * 256 * 2, R_VTA4 = R_VTA1 + (size_t)T * 256 * 2, R_VTA16 = R_VTA4 + (size_t)T * 256 * 2,
                 R_VTCS = R_VTA16 + (size_t)T * 256 * 2, R_VTCW = R_VTCS + (size_t)T * 64 * 2, R_KCMP = R_VTCW + (size_t)T * 64 * 2,
                 R_VTCMP = R_KCMP + (size_t)NB * 512 * 64 * 2, R_KFCS = R_VTCMP + (size_t)NB * 512 * 64 * 2, R_KFCW = R_KFCS + (size_t)T * 64 * 2, R_KFA1 = R_KFCW + (size_t)T * 64 * 2, R_END1 = R_KFA1 + (size_t)T * 256 * 2;
constexpr size_t R_MB = WS_R, R_GS = R_MB + (size_t)T * 1024 * 2, R_MACC = R_GS + (size_t)256 * 65536 * 2, R_END2 = R_MACC + (size_t)256 * 65536 * 2;
constexpr size_t WS_NEED = (R_END1 > R_END2 ? R_END1 : R_END2);
constexpr size_t WS_BAR = (WS_NEED + 255) & ~(size_t)255, WS_TOTAL = WS_BAR + 16384;
constexpr int LDS_RING = 131072, LDS_BYTES = LDS_RING + 64;

struct Params { const float* in[17]; float* out; unsigned char* ws; int ph_lo, ph_hi; };

DEV float ex2(float x) { return __builtin_amdgcn_exp2f(x); }
DEV float lg2(float x) { return __builtin_amdgcn_logf(x); }
DEV float rcp(float x) { return __builtin_amdgcn_rcpf(x); }
DEV float sigm(float x) { return rcp(1.f + ex2(-LOG2E * x)); }
typedef __bf16 bf16x2_t __attribute__((ext_vector_type(2)));
DEV unsigned pk2(float lo, float hi) { const f32x2 v = {lo, hi}; const bf16x2_t b = __builtin_convertvector(v, bf16x2_t); return __builtin_bit_cast(unsigned, b); }
DEV float bflo(unsigned u) { return __builtin_bit_cast(float, u << 16); }
DEV float bfhi(unsigned u) { return __builtin_bit_cast(float, u & 0xffff0000u); }
DEV float bf2f(bf16_t v) { return __builtin_bit_cast(float, (unsigned)v << 16); }
DEV void xhalf_pair(float x, float& a, float& b) {
    a = x;
    asm volatile("v_mov_b32 %1, %0\n\ts_nop 1\n\tv_permlane32_swap_b32 %0, %1\n\ts_nop 1" : "+v"(a), "=&v"(b));
}
template <int CTRL> DEV float dpp_quad(float x) { return __builtin_bit_cast(float, __builtin_amdgcn_update_dpp(0, __builtin_bit_cast(int, x), CTRL, 0xF, 0xF, false)); }
DEV float xhalf_get(float x, int hf) { float a, b; xhalf_pair(x, a, b); return hf ? a : b; }
DEV float xhalf_max(float x) { float a, b; xhalf_pair(x, a, b); return fmaxf(a, b); }
DEV float xhalf_sum(float x) { float a, b; xhalf_pair(x, a, b); return a + b; }
DEV float wave_sum(float v) {
#pragma unroll
    for (int o = 32; o; o >>= 1) v += __shfl_xor(v, o);
    return v;
}
DEV bf16x8 pack8(float a0, float a1, float a2, float a3, float a4, float a5, float a6, float a7) {
    u32x4 w; w.x = pk2(a0, a1); w.y = pk2(a2, a3); w.z = pk2(a4, a5); w.w = pk2(a6, a7); return __builtin_bit_cast(bf16x8, w);
}
#define MFMA32(a, b, c) __builtin_amdgcn_mfma_f32_32x32x16_bf16((a), (b), (c), 0, 0, 0)
DEV f32x16 zero16() { f32x16 z;
#pragma unroll
    for (int j = 0; j < 16; ++j) z[j] = 0.f; return z; }
DEV int kap(int j, int hf) { return 8 * (j >> 2) + 4 * hf + (j & 3); }

DEV int orig_col(int n) {
    if (n < 1024) return n;
    if (n < 1280) return n - 1024 + 1376;
    if (n < 1536) return n - 1280 + 1632;
    if (n < 1792) return n - 1536 + 2284;
    if (n < 2048) return n - 1792 + 2540;
    if (n < 2304) return n - 2048 + 2796;
    if (n < 2560) return n - 2304 + 3052;
    if (n < 2816) return n - 2560 + 3308;
    if (n < 3008) return n - 2816 + 1024;
    if (n < 3136) return n - 3008 + 1216;
    if (n < 3168) return n - 3136 + 1344;
    if (n < 3552) return n - 3168 + 1888;
    if (n < 3564) return n - 3552 + 2272;
    return -1;
}

namespace pg8 {
constexpr int BM = 256, BK = 64, HALF = 128, HTB = HALF * BK * 2;
DEV int lds_byte(int r, int c) { const int st = (r >> 4) * 2 + (c >> 5), rr = r & 15, cc = c & 31, ob = rr * 64 + cc * 2; return st * 1024 + (ob ^ (((ob >> 9) & 1) << 5)); }
DEV void stage_rc(int b, int& R, int& C) { const int st = b / 1024, sb = b % 1024, swz = sb ^ (((sb >> 9) & 1) << 5); R = (st >> 1) * 16 + swz / 64; C = (st & 1) * 32 + (swz % 64) / 2; }
DEV int perm32(int rho) { const int n = rho >> 4, i = rho & 15; return 8 * (i >> 2) + 4 * n + (i & 3); }

struct GUnit { const char* A; const char* B; int lda2, ldb2, nt, kind, pm, pn; };

template <class Epi, class Sched>
DEV void gemm_phase(LAS unsigned char* lds, const Sched& S, const Epi& E, const int tid) {
    const int wid = __builtin_amdgcn_readfirstlane(tid >> 6), lane = tid & 63, wr = wid >> 2, wc = wid & 3, fr = lane & 15, fq = lane >> 4;
    int R0, C0; stage_rc(tid * 16, R0, C0);
    const int Rb0 = (R0 & ~31) + perm32(R0 & 31);
    const unsigned c2 = (unsigned)C0 * 2u;
    const unsigned ldsw = (unsigned)wid * 1024u;
    const int aoff = lds_byte(wr * 64 + fr, fq * 8), boff = lds_byte(wc * 32 + fr, fq * 8);
    const size_t kstep = (size_t)(BK * 2);
#define PG8_SA(b, h) (((b) * 2 + (h)) * HTB)
#define PG8_SB(b, h) ((4 + (b) * 2 + (h)) * HTB)
#define PG8_STAGE(bufoff, gbase, RR, ld2) do { _Pragma("unroll") for (int _i = 0; _i < 2; ++_i) \
        __builtin_amdgcn_global_load_lds((const unsigned*)((const char*)(gbase) + (size_t)((unsigned)((RR) + 64 * _i) * (unsigned)(ld2) + c2)), (LAS unsigned*)(lds + (bufoff) + ldsw + _i * 8192), 16, 0, 0); } while (0)
#define PG8_LDA(dst, b, h) do { _Pragma("unroll") for (int m = 0; m < 4; ++m) _Pragma("unroll") for (int k = 0; k < 2; ++k) dst[m][k] = *(const LAS bf16x8*)(lds + PG8_SA(b, h) + aoff + m * 2048 + k * 1024); } while (0)
#define PG8_LDB(dst, b, h) do { _Pragma("unroll") for (int n = 0; n < 2; ++n) _Pragma("unroll") for (int k = 0; k < 2; ++k) dst[n][k] = *(const LAS bf16x8*)(lds + PG8_SB(b, h) + boff + n * 2048 + k * 1024); } while (0)
#define PG8_MMA(ai, bj, At, Bt) do { __builtin_amdgcn_s_setprio(1); _Pragma("unroll") for (int m = 0; m < 4; ++m) _Pragma("unroll") for (int n = 0; n < 2; ++n) _Pragma("unroll") for (int k = 0; k < 2; ++k) \
        acc[ai][bj][m][n] = __builtin_amdgcn_mfma_f32_16x16x32_bf16(Bt[n][k], At[m][k], acc[ai][bj][m][n], 0, 0, 0); __builtin_amdgcn_s_setprio(0); } while (0)
#define PG8_WAIT_V(n) asm volatile("s_waitcnt vmcnt(" #n ")" ::: "memory")
#define PG8_WAIT_L(n) asm volatile("s_waitcnt lgkmcnt(" #n ")" ::: "memory")
#define PG8_BAR __builtin_amdgcn_s_barrier()
#define PG8_SCHED __builtin_amdgcn_sched_barrier(0)
    GUnit cur, nxt; int ui = 0;
    if (!S.next(0, cur)) return;
    f32x4 acc[2][2][4][2];
#pragma unroll
    for (int a = 0; a < 2; ++a)
#pragma unroll
        for (int b = 0; b < 2; ++b)
#pragma unroll
            for (int m = 0; m < 4; ++m)
#pragma unroll
                for (int n = 0; n < 2; ++n) acc[a][b][m][n] = (f32x4){0.f, 0.f, 0.f, 0.f};
    bf16x8 At[4][2], B0[2][2], B1[2][2];
    const char* cA = cur.A; const char* cB = cur.B; int clda = cur.lda2, cldb = cur.ldb2;
    {
        const size_t chA = (size_t)HALF * clda, chB = (size_t)HALF * cldb;
        PG8_STAGE(PG8_SB(0, 0), cB, Rb0, cldb); PG8_STAGE(PG8_SB(0, 1), cB + chB, Rb0, cldb); PG8_STAGE(PG8_SA(0, 0), cA, R0, clda); PG8_STAGE(PG8_SA(0, 1), cA + chA, R0, clda);
        if (wr == 1) PG8_BAR;
        PG8_WAIT_V(2); PG8_BAR;
        PG8_STAGE(PG8_SB(1, 0), cB + kstep, Rb0, cldb); PG8_STAGE(PG8_SA(1, 0), cA + kstep, R0, clda); PG8_STAGE(PG8_SB(1, 1), cB + chB + kstep, Rb0, cldb);
        PG8_WAIT_V(6); PG8_BAR;
    }
    for (;;) {
        const bool has_next = S.next(ui + 1, nxt);
        const char* nA = has_next ? nxt.A : cA; const char* nB = has_next ? nxt.B : cB;
        const int nlda = has_next ? nxt.lda2 : clda, nldb = has_next ? nxt.ldb2 : cldb;
        const int nt = cur.nt;
        const size_t chA = (size_t)HALF * clda;
        for (int t = 0; t < nt; t += 2) {
            const bool last = (t == nt - 2);
            const char* a1 = cA + (size_t)(t + 1) * kstep;
            const char* a2 = last ? nA : cA + (size_t)(t + 2) * kstep; const char* b2 = last ? nB : cB + (size_t)(t + 2) * kstep;
            const int l2a = last ? nlda : clda, l2b = last ? nldb : cldb;
            const size_t h2a = (size_t)HALF * l2a, h2b = (size_t)HALF * l2b;
            const char* a3 = a2 + kstep; const char* b3 = b2 + kstep;
            PG8_LDB(B0, 0, 0); PG8_LDB(B1, 0, 1); PG8_SCHED; PG8_LDA(At, 0, 0); PG8_STAGE(PG8_SA(1, 1), a1 + chA, R0, clda);
            PG8_WAIT_V(8); PG8_WAIT_L(0); PG8_BAR; PG8_MMA(0, 0, At, B0); PG8_MMA(0, 1, At, B1); PG8_BAR; PG8_SCHED;
            PG8_LDA(At, 0, 1); PG8_STAGE(PG8_SB(0, 0), b2, Rb0, l2b); PG8_STAGE(PG8_SB(0, 1), b2 + h2b, Rb0, l2b); PG8_STAGE(PG8_SA(0, 0), a2, R0, l2a);
            PG8_WAIT_V(8); PG8_WAIT_L(0); PG8_BAR; PG8_MMA(1, 0, At, B0); PG8_MMA(1, 1, At, B1); PG8_BAR; PG8_SCHED;
            PG8_LDB(B0, 1, 0); PG8_LDB(B1, 1, 1); PG8_SCHED; PG8_LDA(At, 1, 0); PG8_STAGE(PG8_SA(0, 1), a2 + h2a, R0, l2a);
            PG8_WAIT_V(8); PG8_WAIT_L(0); PG8_BAR; PG8_MMA(0, 0, At, B0); PG8_MMA(0, 1, At, B1); PG8_BAR; PG8_SCHED;
            PG8_LDA(At, 1, 1); PG8_STAGE(PG8_SB(1, 0), b3, Rb0, l2b); PG8_STAGE(PG8_SB(1, 1), b3 + h2b, Rb0, l2b); PG8_STAGE(PG8_SA(1, 0), a3, R0, l2a);
            PG8_WAIT_V(8); PG8_WAIT_L(0); PG8_BAR; PG8_MMA(1, 0, At, B0); PG8_MMA(1, 1, At, B1); PG8_BAR; PG8_SCHED;
        }
        if (wr == 0) PG8_BAR;
        E(acc, cur, wr, wc, fr, fq);
        if (!has_next) break;
#pragma unroll
        for (int a = 0; a < 2; ++a)
#pragma unroll
            for (int b = 0; b < 2; ++b)
#pragma unroll
                for (int m = 0; m < 4; ++m)
#pragma unroll
                    for (int n = 0; n < 2; ++n) acc[a][b][m][n] = (f32x4){0.f, 0.f, 0.f, 0.f};
        cur = nxt; cA = nA; cB = nB; clda = nlda; cldb = nldb; ++ui;
        if (wr == 1) PG8_BAR;
    }
    PG8_WAIT_V(0);
    PG8_BAR;
#undef PG8_SA
#undef PG8_SB
#undef PG8_STAGE
#undef PG8_LDA
#undef PG8_LDB
#undef PG8_MMA
#undef PG8_WAIT_V
#undef PG8_WAIT_L
#undef PG8_BAR
#undef PG8_SCHED
}

struct SchedIn {
    const char* H; const char* W; int G, c;
    DEV bool next(int i, GUnit& u) const {
        const int L = i * G + c; if (L >= 128 * 14) return false;
        u.pm = L & 127; u.pn = L >> 7; u.kind = 0; u.nt = 16; u.lda2 = 2048; u.ldb2 = 2048;
        u.A = H + (size_t)u.pm * 256 * 2048; u.B = W + (size_t)u.pn * 256 * 2048; return true;
    }
};
struct SchedMerge {
    const char* H; const char* Cb; const char* WMG; const char* WBR; int G, c;
    DEV bool next(int i, GUnit& u) const {
        const int p = i >> 3, st = i & 7; const int L = p * G + c; if (L >= 512) return false;
        u.pm = (L & 7) | ((L >> 5) << 3); u.pn = (L >> 3) & 3; u.kind = st; const int br = st >> 1;
        if (!(st & 1)) { u.A = H + (size_t)u.pm * 256 * 2048; u.lda2 = 2048; u.B = WMG + (size_t)(br * 1024 + u.pn * 256) * 2048; u.ldb2 = 2048; u.nt = 16; }
        else { const int gc = br == 0 ? A_G : br == 1 ? B_G : br == 2 ? C_G : D_G;
               u.A = Cb + ((size_t)u.pm * 256 * CP + gc) * 2; u.lda2 = CP * 2; u.B = WBR + (size_t)(br * 1024 + u.pn * 256) * 512; u.ldb2 = 512; u.nt = 4; }
        return true;
    }
};
struct SchedOut {
    const char* Mb; const char* W; int G, c;
    DEV bool next(int i, GUnit& u) const {
        const int L = i * G + c; if (L >= 512) return false;
        u.pm = (L & 7) | ((L >> 5) << 3); u.pn = (L >> 3) & 3; u.kind = 0; u.nt = 16; u.lda2 = 2048; u.ldb2 = 2048;
        u.A = Mb + (size_t)u.pm * 256 * 2048; u.B = W + (size_t)u.pn * 256 * 2048; return true;
    }
};

struct EpiIn {
    bf16_t* C;
    DEV void operator()(const f32x4 (&acc)[2][2][4][2], const GUnit& u, int wr, int wc, int fr, int fq) const {
        const int row0 = u.pm * BM + wr * 64 + fr, col0 = u.pn * BM + wc * 32 + 8 * fq;
#pragma unroll
        for (int ai = 0; ai < 2; ++ai)
#pragma unroll
            for (int m = 0; m < 4; ++m) { bf16_t* rowp = C + (size_t)(row0 + ai * HALF + m * 16) * CP + col0;
#pragma unroll
                for (int bj = 0; bj < 2; ++bj) { const f32x4 v0 = acc[ai][bj][m][0], v1 = acc[ai][bj][m][1];
                    u32x4 w; w.x = pk2(v0[0], v0[1]); w.y = pk2(v0[2], v0[3]); w.z = pk2(v1[0], v1[1]); w.w = pk2(v1[2], v1[3]);
                    *(u32x4*)(rowp + bj * HALF) = w; } }
    }
};
struct EpiMerge {
    const float* bm;
    bf16_t* Gs; bf16_t* Macc; bf16_t* Mb;
    DEV void operator()(const f32x4 (&acc)[2][2][4][2], const GUnit& u, int wr, int wc, int fr, int fq) const {
        const int br = u.kind >> 1;
        int rr0 = wr * 64 + fr, cc0 = wc * 32 + 8 * fq;
        asm volatile("" : "+v"(rr0), "+v"(cc0));
        if (!(u.kind & 1)) {
            f32x4 bv[2][2];
#pragma unroll
            for (int bj = 0; bj < 2; ++bj)
#pragma unroll
                for (int n = 0; n < 2; ++n) bv[bj][n] = *(const f32x4*)(bm + br * 1024 + u.pn * 256 + cc0 + bj * HALF + 4 * n);
#pragma unroll
            for (int ai = 0; ai < 2; ++ai)
#pragma unroll
                for (int m = 0; m < 4; ++m) { const int rr = rr0 + ai * HALF + m * 16;
#pragma unroll
                    for (int bj = 0; bj < 2; ++bj) { const f32x4 v0 = acc[ai][bj][m][0] + bv[bj][0], v1 = acc[ai][bj][m][1] + bv[bj][1];
                        u32x4 w; w.x = pk2(sigm(v0[0]), sigm(v0[1])); w.y = pk2(sigm(v0[2]), sigm(v0[3])); w.z = pk2(sigm(v1[0]), sigm(v1[1])); w.w = pk2(sigm(v1[2]), sigm(v1[3]));
                        *(u32x4*)(Gs + rr * 256 + cc0 + bj * HALF) = w; } }
        } else {
#pragma unroll
            for (int ai = 0; ai < 2; ++ai)
#pragma unroll
                for (int bj = 0; bj < 2; ++bj) {
                    const int idx0 = (rr0 + ai * HALF) * 256 + cc0 + bj * HALF;
                    u32x4 g[4], mc[4];
#pragma unroll
                    for (int m = 0; m < 4; ++m) g[m] = __builtin_nontemporal_load((const u32x4*)(Gs + idx0 + m * 4096));
                    if (br > 0) {
#pragma unroll
                        for (int m = 0; m < 4; ++m) mc[m] = __builtin_nontemporal_load((const u32x4*)(Macc + idx0 + m * 4096));
                    }
#pragma unroll
                    for (int m = 0; m < 4; ++m) { const int idx = idx0 + m * 4096;
                        f32x4 v0 = acc[ai][bj][m][0], v1 = acc[ai][bj][m][1];
                        v0[0] *= bflo(g[m].x); v0[1] *= bfhi(g[m].x); v0[2] *= bflo(g[m].y); v0[3] *= bfhi(g[m].y);
                        v1[0] *= bflo(g[m].z); v1[1] *= bfhi(g[m].z); v1[2] *= bflo(g[m].w); v1[3] *= bfhi(g[m].w);
                        if (br > 0) { v0[0] += bflo(mc[m].x); v0[1] += bfhi(mc[m].x); v0[2] += bflo(mc[m].y); v0[3] += bfhi(mc[m].y);
                                      v1[0] += bflo(mc[m].z); v1[1] += bfhi(mc[m].z); v1[2] += bflo(mc[m].w); v1[3] += bfhi(mc[m].w); }
                        u32x4 w; w.x = pk2(v0[0], v0[1]); w.y = pk2(v0[2], v0[3]); w.z = pk2(v1[0], v1[1]); w.w = pk2(v1[2], v1[3]);
                        if (br < 3) *(u32x4*)(Macc + idx) = w;
                        else { *(u32x4*)(Mb + (size_t)(u.pm * BM + rr0 + ai * HALF + m * 16) * 1024 + u.pn * BM + cc0 + bj * HALF) = w; } }
                }
        }
    }
};
struct EpiOut {
    const float* xin; float* xout;
    DEV void operator()(const f32x4 (&acc)[2][2][4][2], const GUnit& u, int wr, int wc, int fr, int fq) const {
        const int row0 = u.pm * BM + wr * 64 + fr, col0 = u.pn * BM + wc * 32 + 8 * fq;
#pragma unroll
        for (int ai = 0; ai < 2; ++ai)
#pragma unroll
            for (int m = 0; m < 4; ++m) { const size_t ro = (size_t)(row0 + ai * HALF + m * 16) * 1024 + col0;
#pragma unroll
                for (int bj = 0; bj < 2; ++bj) { const size_t o = ro + bj * HALF;
                    const f32x4 x0 = *(const f32x4*)(xin + o), x1 = *(const f32x4*)(xin + o + 4);
                    *(f32x4*)(xout + o) = x0 + acc[ai][bj][m][0]; *(f32x4*)(xout + o + 4) = x1 + acc[ai][bj][m][1]; } }
    }
};
}

struct TJob { const float* src; int srcld; int mode; bf16_t* dst; int K; int n0, k0; };
DEV void transpose_tile(const TJob& j, LAS float* tile, const int tid) {
    { const int nl = tid & 63, kr = tid >> 6; const int n = j.n0 + nl; const int col = j.mode ? orig_col(n) : n;
#pragma unroll
      for (int ps = 0; ps < 8; ++ps) { const int k = ps * 8 + kr; tile[k * 65 + nl] = (col >= 0) ? j.src[(size_t)(j.k0 + k) * j.srcld + col] : 0.f; } }
    __syncthreads();
    { const int kk = (tid & 31) * 2, nr = tid >> 5;
#pragma unroll
      for (int ps = 0; ps < 4; ++ps) { const int nn = ps * 16 + nr; *(unsigned*)(j.dst + (size_t)(j.n0 + nn) * j.K + j.k0 + kk) = pk2(tile[kk * 65 + nn], tile[(kk + 1) * 65 + nn]); } }
    __syncthreads();
}
constexpr int TJ_IN = 56 * 16, TJ_MG = 4 * 256, TJ_BR = 4 * 64, TJ_OUT = 256, TJ_UQ = 18, TJ_UKV = 16, TJ_W1 = 128, TJ_W2 = 4;
constexpr int TJ_LAYER = TJ_IN + TJ_MG + TJ_BR + TJ_OUT + TJ_UQ + TJ_UKV + TJ_W1 + TJ_W2;
DEV void make_tjob(const Params& p, unsigned char* ws, int idx, TJob& j) {
    const int l = idx / TJ_LAYER; int i = idx % TJ_LAYER;
    unsigned char* wl = ws + (size_t)l * W_LAYER;
    j.mode = 0;
    if (i < TJ_IN) { j.src = p.in[2] + (size_t)l * 1024 * 3564; j.srcld = 3564; j.mode = 1; j.dst = (bf16_t*)(wl + W_IN); j.K = 1024; j.n0 = (i / 16) * 64; j.k0 = (i % 16) * 64; return; }
    i -= TJ_IN;
    if (i < TJ_MG) { const int b = i >> 8, r = i & 255; j.src = p.in[13] + (size_t)(l * 4 + b) * 1024 * 1024; j.srcld = 1024; j.dst = (bf16_t*)(wl + W_MG) + (size_t)b * 1024 * 1024; j.K = 1024; j.n0 = (r >> 4) * 64; j.k0 = (r & 15) * 64; return; }
    i -= TJ_MG;
    if (i < TJ_BR) { const int b = i >> 6, r = i & 63; j.src = p.in[12] + (size_t)(l * 4 + b) * 256 * 1024; j.srcld = 1024; j.dst = (bf16_t*)(wl + W_BR) + (size_t)b * 1024 * 256; j.K = 256; j.n0 = (r >> 2) * 64; j.k0 = (r & 3) * 64; return; }
    i -= TJ_BR;
    if (i < TJ_OUT) { j.src = p.in[15] + (size_t)l * 1024 * 1024; j.srcld = 1024; j.dst = (bf16_t*)(wl + W_OUT); j.K = 1024; j.n0 = (i >> 4) * 64; j.k0 = (i & 15) * 64; return; }
    i -= TJ_OUT;
    if (i < TJ_UQ) { j.src = p.in[4] + (size_t)l * 192 * 384; j.srcld = 384; j.dst = (bf16_t*)(wl + W_UQ); j.K = 192; j.n0 = (i / 3) * 64; j.k0 = (i % 3) * 64; return; }
    i -= TJ_UQ;
    if (i < TJ_UKV) { j.src = p.in[6] + (size_t)l * 128 * 512; j.srcld = 512; j.dst = (bf16_t*)(wl + W_UKV); j.K = 128; j.n0 = (i >> 1) * 64; j.k0 = (i & 1) * 64; return; }
    i -= TJ_UKV;
    if (i < TJ_W1) { const int b = i >> 6, r = i & 63; j.src = p.in[8] + (size_t)(l * 2 + b) * 2048 * 128; j.srcld = 128; j.dst = (bf16_t*)(wl + W_W1) + (size_t)b * 128 * 2048; j.K = 2048; j.n0 = (r >> 5) * 64; j.k0 = (r & 31) * 64; return; }
    i -= TJ_W1;
    { const int b = i >> 1, r = i & 1; j.src = p.in[10] + (size_t)(l * 2 + b) * 128 * 64; j.srcld = 64; j.dst = (bf16_t*)(wl + W_W2) + (size_t)b * 64 * 128; j.K = 128; j.n0 = 0; j.k0 = r * 64; }
}

DEV void rmsnorm_rows_bf16(const float* x, const float* g, bf16_t* H, int gw, int nW, int lane) {
    for (int r0 = gw * 4; r0 < T; r0 += nW * 4) {
        f32x4 v[4][4]; float ss[4];
#pragma unroll
        for (int i = 0; i < 4; ++i) { const f32x4* xr = (const f32x4*)(x + (size_t)(r0 + i) * 1024);
#pragma unroll
            for (int j = 0; j < 4; ++j) v[i][j] = __builtin_nontemporal_load(xr + lane + 64 * j); }
#pragma unroll
        for (int i = 0; i < 4; ++i) { float s = 0.f;
#pragma unroll
            for (int j = 0; j < 4; ++j) s += v[i][j][0] * v[i][j][0] + v[i][j][1] * v[i][j][1] + v[i][j][2] * v[i][j][2] + v[i][j][3] * v[i][j][3];
            ss[i] = s; }
#pragma unroll
        for (int o = 32; o; o >>= 1) {
#pragma unroll
            for (int i = 0; i < 4; ++i) ss[i] += __shfl_xor(ss[i], o); }
#pragma unroll
        for (int i = 0; i < 4; ++i) { const float rs = rsqrtf(ss[i] * (1.0f / 1024.0f) + 1e-6f);
#pragma unroll
            for (int j = 0; j < 4; ++j) { const f32x4 gg = ((const f32x4*)g)[lane + 64 * j];
                u32x2 o; o.x = pk2(v[i][j][0] * rs * gg[0], v[i][j][1] * rs * gg[1]); o.y = pk2(v[i][j][2] * rs * gg[2], v[i][j][3] * rs * gg[3]);
                *(u32x2*)(H + (size_t)(r0 + i) * 1024 + (lane + 64 * j) * 4) = o; } }
    }
}
DEV void rmsnorm_rows_f32(float* x, const float* g, int gw, int nW, int lane) {
    for (int r0 = gw * 4; r0 < T; r0 += nW * 4) {
        f32x4 v[4][4]; float ss[4];
#pragma unroll
        for (int i = 0; i < 4; ++i) { const f32x4* xr = (const f32x4*)(x + (size_t)(r0 + i) * 1024);
#pragma unroll
            for (int j = 0; j < 4; ++j) v[i][j] = __builtin_nontemporal_load(xr + lane + 64 * j); }
#pragma unroll
        for (int i = 0; i < 4; ++i) { float s = 0.f;
#pragma unroll
            for (int j = 0; j < 4; ++j) s += v[i][j][0] * v[i][j][0] + v[i][j][1] * v[i][j][1] + v[i][j][2] * v[i][j][2] + v[i][j][3] * v[i][j][3];
            ss[i] = s; }
#pragma unroll
        for (int o = 32; o; o >>= 1) {
#pragma unroll
            for (int i = 0; i < 4; ++i) ss[i] += __shfl_xor(ss[i], o); }
#pragma unroll
        for (int i = 0; i < 4; ++i) { const float rs = rsqrtf(ss[i] * (1.0f / 1024.0f) + 1e-6f); f32x4* xr = (f32x4*)(x + (size_t)(r0 + i) * 1024);
#pragma unroll
            for (int j = 0; j < 4; ++j) { const f32x4 gg = ((const f32x4*)g)[lane + 64 * j]; __builtin_nontemporal_store(v[i][j] * rs * gg, xr + lane + 64 * j); } }
    }
}

DEV void rope_cs(int pos, int i, float& cs, float& sn) {
    const float inv = exp2f(-(float)i * (13.287712379549449f / 16.0f));
    const float ang = (float)pos * inv;
    double a = (double)ang * 0.15915494309189535; a -= rint(a);
    const float fr = (float)a;
    sn = __builtin_amdgcn_sinf(fr); cs = __builtin_amdgcn_cosf(fr);
}

DEV void mla_q_item(const bf16_t* C, const float* gq, const bf16_t* Wuq, bf16_t* Qb, int item, int lane) {
    const int n = lane & 31, hf = lane >> 5;
    const size_t tok = (size_t)item * 32 + n; const int pos = (int)(tok & (S - 1));
    const bf16_t* row = C + tok * CP + B_CQ + hf * 8;
    bf16x8 xf[12]; float ss = 0.f;
#pragma unroll
    for (int ks = 0; ks < 12; ++ks) { xf[ks] = *(const bf16x8*)(row + ks * 16);
#pragma unroll
        for (int e = 0; e < 8; ++e) { const float v = bf2f((bf16_t)xf[ks][e]); ss += v * v; } }
    ss += __shfl_xor(ss, 32);
    const float rs = rsqrtf(ss * (1.0f / 192.0f) + 1e-6f);
#pragma unroll
    for (int ks = 0; ks < 12; ++ks) { const f32x4 g0 = *(const f32x4*)(gq + ks * 16 + hf * 8), g1 = *(const f32x4*)(gq + ks * 16 + hf * 8 + 4);
        float v[8];
#pragma unroll
        for (int e = 0; e < 8; ++e) v[e] = bf2f((bf16_t)xf[ks][e]) * rs * (e < 4 ? g0[e] : g1[e - 4]);
        xf[ks] = pack8(v[0], v[1], v[2], v[3], v[4], v[5], v[6], v[7]); }
    float cs[8], sn[8];
#pragma unroll
    for (int j = 0; j < 8; ++j) rope_cs(pos, kap(j, hf), cs[j], sn[j]);
    const float QS = 0.10206207261596575f * LOG2E;
#pragma unroll 1
    for (int c = 0; c < 12; ++c) {
        const int head = c / 3, part = c % 3;
        f32x16 acc = zero16();
        const bf16_t* wr_ = Wuq + (size_t)(c * 32 + n) * 192 + hf * 8;
#pragma unroll
        for (int ks = 0; ks < 12; ++ks) acc = MFMA32(*(const bf16x8*)(wr_ + ks * 16), xf[ks], acc);
        if (part == 2) {
#pragma unroll
            for (int j = 0; j < 8; ++j) { const float x1 = acc[j], x2 = acc[j + 8]; acc[j] = x1 * cs[j] - x2 * sn[j]; acc[j + 8] = x1 * sn[j] + x2 * cs[j]; }
        }
        bf16_t* qp = Qb + tok * 384 + head * 96 + part * 32 + hf * 4;
#pragma unroll
        for (int g = 0; g < 4; ++g) { u32x2 o; o.x = pk2(acc[4 * g] * QS, acc[4 * g + 1] * QS); o.y = pk2(acc[4 * g + 2] * QS, acc[4 * g + 3] * QS); *(u32x2*)(qp + g * 8) = o; }
    }
}

DEV void mla_kv_item(const bf16_t* C, const float* gkv, const bf16_t* Wukv, bf16_t* Kb, bf16_t* VTb, int item, int lane) {
    const int n = lane & 31, hf = lane >> 5;
    const size_t tok = (size_t)item * 32 + n; const int pos = (int)(tok & (S - 1)); const int b = (int)(tok >> 13); const int tau = item & 255;
    const bf16_t* row = C + tok * CP + B_CKV + hf * 8;
    bf16x8 xf[8]; float ss = 0.f;
#pragma unroll
    for (int ks = 0; ks < 8; ++ks) { xf[ks] = *(const bf16x8*)(row + ks * 16);
#pragma unroll
        for (int e = 0; e < 8; ++e) { const float v = bf2f((bf16_t)xf[ks][e]); ss += v * v; } }
    ss += __shfl_xor(ss, 32);
    const float rs = rsqrtf(ss * (1.0f / 128.0f) + 1e-6f);
#pragma unroll
    for (int ks = 0; ks < 8; ++ks) { const f32x4 g0 = *(const f32x4*)(gkv + ks * 16 + hf * 8), g1 = *(const f32x4*)(gkv + ks * 16 + hf * 8 + 4);
        float v[8];
#pragma unroll
        for (int e = 0; e < 8; ++e) v[e] = bf2f((bf16_t)xf[ks][e]) * rs * (e < 4 ? g0[e] : g1[e - 4]);
        xf[ks] = pack8(v[0], v[1], v[2], v[3], v[4], v[5], v[6], v[7]); }
    {
        const bf16x8 k1 = *(const bf16x8*)(C + tok * CP + B_KPE + hf * 8), k2 = *(const bf16x8*)(C + tok * CP + B_KPE + 16 + hf * 8);
        float o1[8], o2[8];
#pragma unroll
        for (int e = 0; e < 8; ++e) { float cs, sn; rope_cs(pos, 8 * hf + e, cs, sn); const float x1 = bf2f((bf16_t)k1[e]), x2 = bf2f((bf16_t)k2[e]); o1[e] = x1 * cs - x2 * sn; o2[e] = x1 * sn + x2 * cs; }
        const bf16x8 p1 = pack8(o1[0], o1[1], o1[2], o1[3], o1[4], o1[5], o1[6], o1[7]), p2 = pack8(o2[0], o2[1], o2[2], o2[3], o2[4], o2[5], o2[6], o2[7]);
#pragma unroll
        for (int h = 0; h < 4; ++h) { bf16_t* kt_ = Kb + ((size_t)(b * 4 + h) * 256 + tau) * 3072 + lane * 8; *(bf16x8*)(kt_ + 4 * 512) = p1; *(bf16x8*)(kt_ + 5 * 512) = p2; }
    }
#pragma unroll 1
    for (int c = 0; c < 16; ++c) {
        const int head = c >> 2, part = c & 3;
        f32x16 acc = zero16();
        const bf16_t* wr_ = Wukv + (size_t)(c * 32 + n) * 128 + hf * 8;
#pragma unroll
        for (int ks = 0; ks < 8; ++ks) acc = MFMA32(*(const bf16x8*)(wr_ + ks * 16), xf[ks], acc);
        if (part < 2) {
            bf16_t* kp = Kb + ((size_t)(b * 4 + head) * 256 + tau) * 3072 + n * 8 + 4 * hf;
#pragma unroll
            for (int g = 0; g < 4; ++g) { u32x2 o; o.x = pk2(acc[4 * g], acc[4 * g + 1]); o.y = pk2(acc[4 * g + 2], acc[4 * g + 3]); *(u32x2*)(kp + (part * 2 + (g >> 1)) * 512 + (g & 1) * 256) = o; }
        } else {
            bf16_t* vp = VTb + (((size_t)(b * 4 + head) * 256 + tau) * 4 + (part - 2) * 2 + (n >> 4)) * 512 + ((n >> 2) & 1) * 256 + ((n >> 3) & 1) * 4 + (n & 3);
#pragma unroll
            for (int j = 0; j < 16; ++j) vp[kap(j, hf) * 8] = (bf16_t)(pk2(acc[j], 0.f) & 0xffffu);
        }
    }
}

DEV void vtrans_item(const bf16_t* src  , int tbase, int tstride, bf16_t* dst, size_t rowlen, int lane) {
    const bf16_t* row = src + (size_t)(tbase + lane * tstride) * CP;
    bf16_t* d = dst + lane;
#pragma unroll 2
    for (int i = 0; i < 8; ++i) {
        const bf16x8 v = *(const bf16x8*)(row + i * 8);
#pragma unroll
        for (int e = 0; e < 8; ++e) d[(size_t)e * rowlen] = (bf16_t)v[e];
        d += 8 * rowlen;
    }
}
DEV void vfrag_item(const bf16_t* src  , int tbase, int tstride, bf16_t* dst, int lane) {
    const int n = lane & 31, hf = lane >> 5;
#pragma unroll
    for (int qq = 0; qq < 2; ++qq) {
        bf16_t v[2][8];
#pragma unroll
        for (int e = 0; e < 8; ++e) { const int kp_ = qq * 16 + (e >> 2) * 8 + hf * 4 + (e & 3);
            const bf16_t* row = src + (size_t)(tbase + kp_ * tstride) * CP + n;
            v[0][e] = row[0]; v[1][e] = row[32]; }
#pragma unroll
        for (int d = 0; d < 2; ++d) { u32x4 w; w.x = v[d][0] | ((unsigned)v[d][1] << 16); w.y = v[d][2] | ((unsigned)v[d][3] << 16); w.z = v[d][4] | ((unsigned)v[d][5] << 16); w.w = v[d][6] | ((unsigned)v[d][7] << 16);
            *(u32x4*)(dst + (d * 2 + qq) * 512 + lane * 8) = w; }
    }
}
DEV void kfrag_item(const bf16_t* src, int tbase, bf16_t* dst, int lane) {
    const int n = lane & 31, hf = lane >> 5;
    const bf16_t* row = src + (size_t)(tbase + n) * CP + hf * 8;
#pragma unroll
    for (int ks = 0; ks < 4; ++ks) *(bf16x8*)(dst + ks * 512 + lane * 8) = *(const bf16x8*)(row + ks * 16);
}

DEV void compress_item(const Params& p, unsigned char* ws, int l, int item, LAS float* part, const int tid) {
    const bf16_t* C = (const bf16_t*)(ws + WS_C);
    const int w = tid >> 6, lane = tid & 63, n = lane & 31, hf = lane >> 5;
    const int b = item >> 5, kv = (item >> 4) & 1, ntile = item & 15;
    const int nrow = ntile * 32 + n;
    const bf16_t* W1 = (const bf16_t*)(ws + (size_t)l * W_LAYER + W_W1) + (size_t)kv * 128 * 2048;
    const bf16_t* W2 = (const bf16_t*)(ws + (size_t)l * W_LAYER + W_W2) + (size_t)kv * 64 * 128;
    const float* pe = p.in[7] + (size_t)(l * 2 + kv) * 32 * 64;
    const float* b1 = p.in[9] + (size_t)(l * 2 + kv) * 128;
    const float* b2 = p.in[11] + (size_t)(l * 2 + kv) * 64;
    const int ccol = kv ? C_VC : C_KC;
    f32x16 acc[4];
#pragma unroll
    for (int hc = 0; hc < 4; ++hc) acc[hc] = zero16();
#pragma unroll 1
    for (int li = 0; li < 4; ++li) {
        const int lpos = w * 4 + li;
        int tk = nrow * 16 + lpos; tk = tk < S ? tk : S - 1;
        const bf16_t* trow = C + ((size_t)b * S + tk) * CP + ccol + hf * 8;
        const float* prow = pe + lpos * 64 + hf * 8;
#pragma unroll 1
        for (int ks = 0; ks < 4; ++ks) {
            const bf16x8 tv = *(const bf16x8*)(trow + ks * 16);
            const f32x4 p0 = *(const f32x4*)(prow + ks * 16), p1 = *(const f32x4*)(prow + ks * 16 + 4);
            const bf16x8 xb = pack8(bf2f((bf16_t)tv[0]) + p0[0], bf2f((bf16_t)tv[1]) + p0[1], bf2f((bf16_t)tv[2]) + p0[2], bf2f((bf16_t)tv[3]) + p0[3],
                                    bf2f((bf16_t)tv[4]) + p1[0], bf2f((bf16_t)tv[5]) + p1[1], bf2f((bf16_t)tv[6]) + p1[2], bf2f((bf16_t)tv[7]) + p1[3]);
#pragma unroll
            for (int hc = 0; hc < 4; ++hc) acc[hc] = MFMA32(*(const bf16x8*)(W1 + (size_t)(hc * 32 + n) * 2048 + lpos * 64 + ks * 16 + hf * 8), xb, acc[hc]);
        }
    }
#pragma unroll
    for (int hc = 0; hc < 4; ++hc)
#pragma unroll
        for (int j = 0; j < 16; ++j) part[(w * 128 + hc * 32 + kap(j, hf)) * 32 + n] = acc[hc][j];
    __syncthreads();
#pragma unroll 1
    for (int i = 0; i < 8; ++i) { const int e = tid + 512 * i; float s = 0.f;
#pragma unroll
        for (int ww = 0; ww < 8; ++ww) s += part[ww * 4096 + e];
        s += b1[e >> 5];
        const float u = 0.7978845608028654f * (s + 0.044715f * s * s * s);
        const float th = 1.f - 2.f * rcp(1.f + ex2(2.f * LOG2E * u));
        part[e] = 0.5f * s * (1.f + th); }
    __syncthreads();
    if (w < 2) {
        f32x16 a2 = zero16();
#pragma unroll
        for (int ks = 0; ks < 8; ++ks) {
            float h[8];
#pragma unroll
            for (int e = 0; e < 8; ++e) h[e] = part[(ks * 16 + hf * 8 + e) * 32 + n];
            a2 = MFMA32(*(const bf16x8*)(W2 + (size_t)(w * 32 + n) * 128 + ks * 16 + hf * 8), pack8(h[0], h[1], h[2], h[3], h[4], h[5], h[6], h[7]), a2);
        }
        if (kv == 0) {
            bf16_t* kp = (bf16_t*)(ws + R_KCMP) + ((size_t)b * 16 + ntile) * 2048 + n * 8 + 4 * hf;
#pragma unroll
            for (int g = 0; g < 4; ++g) { const f32x4 bb = *(const f32x4*)(b2 + w * 32 + g * 8 + hf * 4);
                u32x2 o; o.x = pk2(a2[4 * g] + bb[0], a2[4 * g + 1] + bb[1]); o.y = pk2(a2[4 * g + 2] + bb[2], a2[4 * g + 3] + bb[3]); *(u32x2*)(kp + (w * 2 + (g >> 1)) * 512 + (g & 1) * 256) = o; }
        } else {
            bf16_t* vp = (bf16_t*)(ws + R_VTCMP) + (((size_t)b * 16 + ntile) * 4 + w * 2 + (n >> 4)) * 512 + ((n >> 2) & 1) * 256 + ((n >> 3) & 1) * 4 + (n & 3);
#pragma unroll
            for (int j = 0; j < 16; ++j) { const int r = kap(j, hf); vp[r * 8] = (bf16_t)(pk2(a2[j] + b2[w * 32 + r], 0.f) & 0xffffu); }
        }
    }
    __syncthreads();
}

template <int NK> DEV f32x16 qk_tile(const bf16x8 (&qf)[NK], const bf16_t* krow) {
    f32x16 s = zero16();
#pragma unroll
    for (int ks = 0; ks < NK; ++ks) s = MFMA32(*(const bf16x8*)(krow + ks * 16), qf[ks], s);
    return s;
}
DEV void pv_tile(f32x16 (&O)[2], const f32x16& p, const bf16_t* vt, size_t dv32) {
    const bf16x8 pf0 = pack8(p[0], p[1], p[2], p[3], p[4], p[5], p[6], p[7]), pf1 = pack8(p[8], p[9], p[10], p[11], p[12], p[13], p[14], p[15]);
#pragma unroll
    for (int d = 0; d < 2; ++d) { const bf16_t* r = vt + d * dv32;
        const s16x4 a0 = *(const s16x4*)(r), a1 = *(const s16x4*)(r + 8), a2 = *(const s16x4*)(r + 16), a3 = *(const s16x4*)(r + 24);
        const bf16x8 v0 = __builtin_shufflevector(a0, a1, 0, 1, 2, 3, 4, 5, 6, 7), v1 = __builtin_shufflevector(a2, a3, 0, 1, 2, 3, 4, 5, 6, 7);
        O[d] = MFMA32(v0, pf0, O[d]); O[d] = MFMA32(v1, pf1, O[d]); }
}
template <int NK> struct KVF { bf16x8 k[NK]; bf16x8 v[2][2]; };
template <int NK, int KS, bool LV> DEV void load_kv(KVF<NK>& f, const bf16_t* kp, const bf16_t* vp) {
#pragma unroll
    for (int ks = 0; ks < NK; ++ks) f.k[ks] = *(const bf16x8*)(kp + ks * KS);
    if (LV) {
#pragma unroll
        for (int d = 0; d < 2; ++d)
#pragma unroll
            for (int qq = 0; qq < 2; ++qq) f.v[d][qq] = *(const bf16x8*)(vp + (d * 2 + qq) * 512);
    }
}
template <int NK> DEV f32x16 qk_frag(const bf16x8 (&qf)[NK], const KVF<NK>& f) {
    f32x16 s = zero16();
#pragma unroll
    for (int ks = 0; ks < NK; ++ks) s = MFMA32(f.k[ks], qf[ks], s);
    return s;
}
template <int NK> DEV void pv_frag(f32x16 (&O)[2], const f32x16& p, const KVF<NK>& f) {
    const bf16x8 pf0 = pack8(p[0], p[1], p[2], p[3], p[4], p[5], p[6], p[7]), pf1 = pack8(p[8], p[9], p[10], p[11], p[12], p[13], p[14], p[15]);
#pragma unroll
    for (int d = 0; d < 2; ++d) { O[d] = MFMA32(f.v[d][0], pf0, O[d]); O[d] = MFMA32(f.v[d][1], pf1, O[d]); }
}
template <int NK, int KS, bool LV, class Addr, class Step>
DEV void tile_loop(int t0, int t1, Addr addr, Step step) {
    if (t0 >= t1) return;
    const int tl = t1 - 1;
    KVF<NK> A, B;
    { const bf16_t* kp; const bf16_t* vp; addr(t0, kp, vp); load_kv<NK, KS, LV>(A, kp, vp); }
    { const bf16_t* kp; const bf16_t* vp; addr(t0 + 1 < tl ? t0 + 1 : tl, kp, vp); load_kv<NK, KS, LV>(B, kp, vp); }
    int t = t0;
#pragma unroll 1
    for (; t + 1 < t1; t += 2) {
        step(A, t);
        { const bf16_t* kp; const bf16_t* vp; addr(t + 2 < tl ? t + 2 : tl, kp, vp); load_kv<NK, KS, LV>(A, kp, vp); }
        step(B, t + 1);
        { const bf16_t* kp; const bf16_t* vp; addr(t + 3 < tl ? t + 3 : tl, kp, vp); load_kv<NK, KS, LV>(B, kp, vp); }
    }
    if (t < t1) step(A, t);
}
constexpr float RESCALE_THR = 11.5f;
template <bool LAZY = true> DEV void softmax_update(f32x16& s, float& m, float& l, f32x16 (&O)[2]) {
    float mx = s[0];
#pragma unroll
    for (int j = 1; j < 16; ++j) mx = fmaxf(mx, s[j]);
    mx = xhalf_max(mx);
    const float mn = fmaxf(m, mx);
    if (!LAZY || __builtin_amdgcn_ballot_w64(mx > m + RESCALE_THR) != 0ull) {
        const float al = ex2(m - mn); m = mn; l *= al; O[0] *= al; O[1] *= al;
    }
    float rs = 0.f;
#pragma unroll
    for (int j = 0; j < 16; ++j) { const float pj = ex2(s[j] - m); s[j] = pj; rs += pj; }
    rs = xhalf_sum(rs);
    l += rs;
}
DEV void write_gated(const f32x16 (&O)[2], float sc, bf16_t* gp) {
#pragma unroll
    for (int d = 0; d < 2; ++d)
#pragma unroll
        for (int g = 0; g < 4; ++g) { bf16_t* q = gp + d * 32 + g * 8; const u32x2 gv = *(const u32x2*)q;
            const float g0 = bflo(gv.x), g1 = bfhi(gv.x), g2 = bflo(gv.y), g3 = bfhi(gv.y);
            u32x2 o; o.x = pk2(O[d][4 * g] * sc * g0 * sigm(g0), O[d][4 * g + 1] * sc * g1 * sigm(g1)); o.y = pk2(O[d][4 * g + 2] * sc * g2 * sigm(g2), O[d][4 * g + 3] * sc * g3 * sigm(g3));
            *(u32x2*)q = o; }
}

template <int MODE = 0> DEV void mla_item(unsigned char* ws, int b, int h, int qt, int lane, LAS unsigned char* wlds) {
    const int n = lane & 31, hf = lane >> 5;
    const bf16_t* Qb = (const bf16_t*)(ws + R_QB); const bf16_t* Kb = (const bf16_t*)(ws + R_KB); const bf16_t* VT = (const bf16_t*)(ws + R_VTB); bf16_t* C = (bf16_t*)(ws + WS_C);
    const size_t tok = (size_t)b * S + qt * 32 + n;
    LAS bf16x8* qs = (LAS bf16x8*)wlds + lane;
#pragma unroll
    for (int ks = 0; ks < 6; ++ks) qs[ks * 64] = *(const bf16x8*)(Qb + tok * 384 + h * 96 + hf * 8 + ks * 16);
    f32x16 O[2]; O[0] = zero16(); O[1] = zero16(); float m = NEG, l = 0.f;
    const bf16_t* kp0 = Kb + (size_t)(b * 4 + h) * 256 * 3072 + lane * 8;
    const bf16_t* vp0 = VT + (size_t)(b * 4 + h) * 256 * 2048 + lane * 8;
    tile_loop<6, 512, true>(0, qt + 1,
        [&](int t, const bf16_t*& kp, const bf16_t*& vp) { kp = kp0 + (size_t)t * 3072; vp = vp0 + (size_t)t * 2048; },
        [&](const KVF<6>& f, int t) {
            if (MODE == 3) { bf16x8 x = f.k[0];
#pragma unroll
                for (int ks = 1; ks < 6; ++ks) x ^= f.k[ks];
                x ^= f.v[0][0] ^ f.v[0][1] ^ f.v[1][0] ^ f.v[1][1]; O[0][0] += (float)x[0]; return; }
            f32x16 s = zero16();
#pragma unroll
            for (int ks = 0; ks < 6; ++ks) s = MFMA32(f.k[ks], qs[ks * 64], s);
            if (MODE == 2) { O[0] += s; return; }
            if (t == qt) {
#pragma unroll
                for (int j = 0; j < 16; ++j) if (kap(j, hf) > n) s[j] = NEG;
            }
            softmax_update<true>(s, m, l, O);
            pv_frag<6>(O, s, f);
        });
    if (MODE == 0) write_gated(O, rcp(l), C + tok * CP + B_G + h * 64 + hf * 4);
    else if (O[0][0] + O[1][3] + l == 1.2345e-20f) C[tok * CP + CP - 1] = 0;
}

template <int MODE = 0> DEV void sb_item(unsigned char* ws, int b, int h, int qt, int lane) {
    const int n = lane & 31, hf = lane >> 5;
    bf16_t* C = (bf16_t*)(ws + WS_C); const bf16_t* VT = (const bf16_t*)(ws + R_VTD);
    const size_t tok = (size_t)b * S + qt * 32 + n;
    bf16x8 qf[4];
#pragma unroll
    for (int ks = 0; ks < 4; ++ks) qf[ks] = *(const bf16x8*)(C + tok * CP + D_Q + h * 64 + hf * 8 + ks * 16);
    const float c = 0.125f * LOG2E;
    f32x16 O[2]; O[0] = zero16(); O[1] = zero16(); float carry = 0.f;
    const bf16_t* kp = C + ((size_t)b * S + n) * CP + D_K + h * 64 + hf * 8;
    const bf16_t* vp = VT + ((size_t)(b * 4 + h) * 64 + n) * S + hf * 4;
#pragma unroll 1
    for (int kt = qt; kt >= 0; --kt) {
        f32x16 s = qk_tile<4>(qf, kp + (size_t)kt * 32 * CP);
        f32x16 L;
#pragma unroll
        for (int j = 0; j < 16; ++j) { const float z = s[j] * c; const bool valid = (kt < qt) || (kap(j, hf) < n);
            const float sp = fmaxf(z, 0.f) + lg2(1.f + ex2(-fabsf(z)));
            L[j] = valid ? -sp : 0.f; s[j] = valid ? z : NEG; }
        float sg[4], pg[4];
#pragma unroll
        for (int g = 0; g < 4; ++g) { L[4 * g + 2] += L[4 * g + 3]; L[4 * g + 1] += L[4 * g + 2]; L[4 * g] += L[4 * g + 1]; sg[g] = L[4 * g]; }
#pragma unroll
        for (int g = 0; g < 4; ++g) pg[g] = xhalf_get(sg[g], hf);
        float run = carry;
#pragma unroll
        for (int g = 3; g >= 0; --g) { const float base = run + (hf == 0 ? pg[g] : 0.f);
#pragma unroll
            for (int i = 0; i < 4; ++i) s[4 * g + i] = ex2(s[4 * g + i] + base + L[4 * g + i]);
            run += sg[g] + pg[g]; }
        carry = run;
        pv_tile(O, s, vp + kt * 32, (size_t)32 * S);
        if (__builtin_amdgcn_ballot_w64(carry > -64.f) == 0ull) break;
    }
    if (MODE == 0) write_gated(O, 1.f, C + tok * CP + D_G + h * 64 + hf * 4);
    else if (O[0][0] + O[1][3] == 1.2345e-20f) C[tok * CP + CP - 1] = 0;
}

template <int MODE = 0> DEV void dsw_item(unsigned char* ws, int b, int h, int r, int ut, int lane) {
    const int n = lane & 31, hf = lane >> 5;
    bf16_t* C = (bf16_t*)(ws + WS_C);
    const int tq = r + 16 * (ut * 32 + n);
    const size_t tok = (size_t)b * S + tq;
    bf16x8 qf[4];
#pragma unroll
    for (int ks = 0; ks < 4; ++ks) qf[ks] = *(const bf16x8*)(C + tok * CP + A_Q + h * 64 + hf * 8 + ks * 16);
    const float c = 0.125f * LOG2E, sl2 = LOG2E * 0.5f / (float)(1 << (2 * h));
    f32x16 O[2]; O[0] = zero16(); O[1] = zero16(); float m = NEG, l = 0.f;
    const bf16_t* kb = C + (size_t)b * S * CP + A_K + h * 64 + hf * 8;
    const size_t vrow = (size_t)(b * 4 + h) * 256 * 2048 + lane * 8;
    {
        const bf16_t* vb = (const bf16_t*)(ws + R_VTA16) + vrow + (size_t)r * 16 * 2048;
        const int ub = ut * 32 - 128;
        tile_loop<4, 16, true>(ut < 4 ? 4 - ut : 0, 5,
            [&](int t, const bf16_t*& kp, const bf16_t*& vp) { const int us = ub + t * 32; kp = kb + (size_t)(r + 16 * (us + n)) * CP; vp = vb + (size_t)(us >> 5) * 2048; },
            [&](const KVF<4>& f, int t) { const int us = ub + t * 32; f32x16 s = qk_frag<4>(qf, f);
#pragma unroll
                for (int j = 0; j < 16; ++j) { const int dist = tq - (r + 16 * (us + kap(j, hf))); s[j] = (dist >= 0 && dist <= 2048) ? s[j] * c - sl2 * (float)dist : NEG; }
                softmax_update(s, m, l, O); pv_frag<4>(O, s, f); });
    }
    {
        const int r4 = r & 3;
        const bf16_t* vb = (const bf16_t*)(ws + R_VTA4) + vrow + (size_t)r4 * 64 * 2048;
        const int ub = ut * 128 - 128;
        tile_loop<4, 16, true>(ut == 0 ? 4 : 0, 8,
            [&](int t, const bf16_t*& kp, const bf16_t*& vp) { const int us = ub + t * 32; kp = kb + (size_t)(r4 + 4 * (us + n)) * CP; vp = vb + (size_t)(us >> 5) * 2048; },
            [&](const KVF<4>& f, int t) { const int us = ub + t * 32; f32x16 s = qk_frag<4>(qf, f);
#pragma unroll
                for (int j = 0; j < 16; ++j) { const int dist = tq - (r4 + 4 * (us + kap(j, hf))); s[j] = (dist >= 0 && dist <= 512) ? s[j] * c - sl2 * (float)dist : NEG; }
                softmax_update(s, m, l, O); pv_frag<4>(O, s, f); });
    }
    {
        const bf16_t* vb = (const bf16_t*)(ws + R_VTA1) + vrow;
        const int tb = ut * 512 - 128;
        const bf16_t* kf1 = (const bf16_t*)(ws + R_KFA1) + vrow;
        tile_loop<4, 512, true>(ut == 0 ? 4 : 0, 20,
            [&](int t, const bf16_t*& kp, const bf16_t*& vp) { const int ts = tb + t * 32; kp = kf1 + (size_t)(ts >> 5) * 2048; vp = vb + (size_t)(ts >> 5) * 2048; },
            [&](const KVF<4>& f, int t) { const int ts = tb + t * 32; f32x16 s = qk_frag<4>(qf, f);
#pragma unroll
                for (int j = 0; j < 16; ++j) { const int dist = tq - (ts + kap(j, hf)); s[j] = (dist >= 0 && dist <= 128) ? s[j] * c - sl2 * (float)dist : NEG; }
                softmax_update(s, m, l, O); pv_frag<4>(O, s, f); });
    }
    if (MODE == 0) write_gated(O, rcp(l), C + tok * CP + A_G + h * 64 + hf * 4);
    else if (O[0][0] + O[1][3] + l == 1.2345e-20f) C[tok * CP + CP - 1] = 0;
}

template <int MODE = 0> DEV void nsa_item(unsigned char* ws, int b, int q0, int lane, LAS float* Asel  , LAS float* Bsel  , LAS float* stash  ) {
    const int n = lane & 31, hf = lane >> 5, ql = n >> 2, hd = n & 3;
    bf16_t* C = (bf16_t*)(ws + WS_C);
    const int t = q0 + ql, tmax = q0 + 7;
    const size_t tok = (size_t)b * S + t;
    const float c = 0.125f * LOG2E, sl2 = LOG2E * 0.25f / (float)(1 << (2 * hd));
    bf16x8 qf[4];
#pragma unroll
    for (int ks = 0; ks < 4; ++ks) qf[ks] = *(const bf16x8*)(C + tok * CP + C_Q + hd * 64 + hf * 8 + ks * 16);
    float g0, g1, g2;
    { const bf16_t* gp = C + tok * CP + C_GT + hd * 3; g0 = sigm(bf2f(gp[0])); g1 = sigm(bf2f(gp[1])); g2 = sigm(bf2f(gp[2])); }
#pragma unroll
    for (int i = 0; i < 32; ++i) Asel[lane + 64 * i] = 0.f;
    {
        const int ntiles = (tmax >= 31) ? ((((tmax - 31) >> 4) >> 5) + 1) : 0;
        const bf16_t* kc = (const bf16_t*)(ws + R_KCMP) + (size_t)b * 16 * 2048 + lane * 8;
        const bf16_t* vc = (const bf16_t*)(ws + R_VTCMP) + (size_t)b * 16 * 2048 + lane * 8;
        float m = NEG, l = 0.f;
        auto addr = [&](int nt, const bf16_t*& kp, const bf16_t*& vp) { kp = kc + (size_t)nt * 2048; vp = vc + (size_t)nt * 2048; };
        tile_loop<4, 512, false>(0, ntiles, addr,
            [&](const KVF<4>& f, int nt) { f32x16 s = qk_frag<4>(qf, f);
                float mx = NEG;
#pragma unroll
                for (int j = 0; j < 16; ++j) { const int dist = t - (16 * (nt * 32 + kap(j, hf)) + 31); s[j] = dist >= 0 ? s[j] * c - sl2 * (float)dist : NEG; mx = fmaxf(mx, s[j]); }
                mx = xhalf_max(mx);
                const float mn = fmaxf(m, mx); float rs = 0.f;
#pragma unroll
                for (int j = 0; j < 16; ++j) rs += (s[j] > -1e29f) ? ex2(s[j] - mn) : 0.f;
                rs = xhalf_sum(rs);
                l = l * ex2(m - mn) + rs; m = mn; });
        const float il = l > 0.f ? 1.0f / l : 0.f;
        f32x16 Oc[2]; Oc[0] = zero16(); Oc[1] = zero16();
        tile_loop<4, 512, true>(0, ntiles, addr,
            [&](const KVF<4>& f, int nt) { f32x16 s = qk_frag<4>(qf, f);
#pragma unroll
                for (int j = 0; j < 16; ++j) { const int dist = t - (16 * (nt * 32 + kap(j, hf)) + 31); s[j] = dist >= 0 ? ex2(s[j] * c - sl2 * (float)dist - m) * il : 0.f; }
#pragma unroll
                for (int g = 0; g < 4; ++g) { float a = s[4 * g], bb = a + 2.f * (s[4 * g + 1] + s[4 * g + 2] + s[4 * g + 3]);
                    a += dpp_quad<0xB1>(a); a += dpp_quad<0x4E>(a); bb += dpp_quad<0xB1>(bb); bb += dpp_quad<0x4E>(bb);
                    if (hd == 0) { const int js = nt * 8 + 2 * g + hf; Asel[ql * 128 + js] = a; Bsel[ql * 128 + js] = bb; } }
                pv_frag<4>(Oc, s, f); });
#pragma unroll
        for (int d = 0; d < 2; ++d)
#pragma unroll
            for (int j = 0; j < 16; ++j) stash[(d * 16 + j) * 64 + lane] = Oc[d][j] * g0;
    }
    unsigned long long mylo = 0ull, myhi = 0ull, ulo = 0ull, uhi = 0ull;
#pragma unroll 1
    for (int q = 0; q < 8; ++q) {
        const int tq = q0 + q, cur = tq >> 6;
        LAS float* Aq = Asel + q * 128; LAS float* Bq = Bsel + q * 128;
        unsigned k0, k1; bool va0, va1;
        { const int j = lane; va0 = j * 64 <= tq; const bool forced = (j == 0) || (j == cur) || (j == cur - 1);
          const float ps = Aq[j] + (j > 0 ? Bq[j > 0 ? j - 1 : 0] : 0.f); const float sc = forced ? 1e9f : ps;
          k0 = va0 ? (((__builtin_bit_cast(unsigned, sc) >> 6) << 7) | (unsigned)(127 - j)) : 0u; }
        { const int j = lane + 64; va1 = j * 64 <= tq; const bool forced = (j == cur) || (j == cur - 1);
          const float ps = Aq[j] + Bq[j - 1]; const float sc = forced ? 1e9f : ps;
          k1 = va1 ? (((__builtin_bit_cast(unsigned, sc) >> 6) << 7) | (unsigned)(127 - j)) : 0u; }
        LAS unsigned* Kq = (LAS unsigned*)Aq;
        Kq[lane] = k0; Kq[lane + 64] = k1;
        int r0 = 0, r1 = 0;
#pragma unroll 8
        for (int jj = 0; jj < 128; jj += 4) { const u32x4 v = *(const LAS u32x4*)(Kq + jj);
#pragma unroll
            for (int e = 0; e < 4; ++e) { r0 += (v[e] > k0) ? 1 : 0; r1 += (v[e] > k1) ? 1 : 0; } }
        const unsigned long long lo = __builtin_amdgcn_ballot_w64(va0 && r0 < 16), hi = __builtin_amdgcn_ballot_w64(va1 && r1 < 16);
        ulo |= lo; uhi |= hi; if (ql == q) { mylo = lo; myhi = hi; }
    }
    if (MODE == 2) { if ((ulo ^ uhi ^ mylo) == 0x123456789abcdefull) C[tok * CP + CP - 1] = 0; return; }
    if (MODE != 3) {
        LAS int* list = (LAS int*)Asel;
        int ntl = 0;
#pragma unroll 1
        for (int w = 0; w < 2; ++w) {
            unsigned long long um = w ? uhi : ulo;
            while (um) { const int bit = __builtin_ctzll(um); um &= um - 1ull; const int ts = (bit + 64 * w) * 64;
                if (ts <= tmax) { list[ntl++] = ts; if (ts + 32 <= tmax) list[ntl++] = ts + 32; } }
        }
        f32x16 O[2]; O[0] = zero16(); O[1] = zero16(); float m = NEG, l = 0.f;
        const bf16_t* kb = (const bf16_t*)(ws + R_KFCS) + (size_t)b * 256 * 2048 + lane * 8;
        const bf16_t* vb = (const bf16_t*)(ws + R_VTCS) + (size_t)b * 256 * 2048 + lane * 8;
        tile_loop<4, 512, true>(0, ntl,
            [&](int i, const bf16_t*& kp, const bf16_t*& vp) { const int ts = __builtin_amdgcn_readfirstlane(list[i]); kp = kb + (size_t)(ts >> 5) * 2048; vp = vb + (size_t)(ts >> 5) * 2048; },
            [&](const KVF<4>& f, int i) { const int ts = __builtin_amdgcn_readfirstlane(list[i]); const int jb = ts >> 6;
                const bool mysel = ((jb < 64 ? (mylo >> jb) : (myhi >> (jb - 64))) & 1ull) != 0ull;
                f32x16 s = qk_frag<4>(qf, f);
                if (ts + 31 <= q0) {
                    const float bt = mysel ? -sl2 * (float)(t - ts - 4 * hf) : NEG;
#pragma unroll
                    for (int j = 0; j < 16; ++j) s[j] = fmaf(s[j], c, fmaf((float)(8 * (j >> 2) + (j & 3)), sl2, bt));
                } else {
#pragma unroll
                    for (int j = 0; j < 16; ++j) { const int dist = t - (ts + kap(j, hf)); s[j] = (mysel && dist >= 0) ? s[j] * c - sl2 * (float)dist : NEG; }
                }
                softmax_update(s, m, l, O); pv_frag<4>(O, s, f); });
        const float sc = g1 * rcp(l);
#pragma unroll
        for (int d = 0; d < 2; ++d)
#pragma unroll
            for (int j = 0; j < 16; ++j) stash[(d * 16 + j) * 64 + lane] += O[d][j] * sc;
    }
    {
        f32x16 O[2]; O[0] = zero16(); O[1] = zero16(); float m = NEG, l = 0.f;
        const bf16_t* kb = (const bf16_t*)(ws + R_KFCW) + (size_t)b * 256 * 2048 + lane * 8;
        const bf16_t* vb = (const bf16_t*)(ws + R_VTCW) + (size_t)b * 256 * 2048 + lane * 8;
        const int ws0 = (q0 > 511 ? q0 - 511 : 0) & ~31;
        tile_loop<4, 512, true>(0, ((tmax - ws0) >> 5) + 1,
            [&](int i, const bf16_t*& kp, const bf16_t*& vp) { const int ts = ws0 + i * 32; kp = kb + (size_t)(ts >> 5) * 2048; vp = vb + (size_t)(ts >> 5) * 2048; },
            [&](const KVF<4>& f, int i) { const int ts = ws0 + i * 32; f32x16 s = qk_frag<4>(qf, f);
                if (ts + 31 <= q0 && ts >= q0 - 504) {
                    const float bt = -sl2 * (float)(t - ts - 4 * hf);
#pragma unroll
                    for (int j = 0; j < 16; ++j) s[j] = fmaf(s[j], c, fmaf((float)(8 * (j >> 2) + (j & 3)), sl2, bt));
                } else {
#pragma unroll
                    for (int j = 0; j < 16; ++j) { const int dist = t - (ts + kap(j, hf)); s[j] = (dist >= 0 && dist < 512) ? s[j] * c - sl2 * (float)dist : NEG; }
                }
                softmax_update(s, m, l, O); pv_frag<4>(O, s, f); });
        const float sc = g2 * rcp(l);
#pragma unroll
        for (int d = 0; d < 2; ++d)
#pragma unroll
            for (int j = 0; j < 16; ++j) O[d][j] = O[d][j] * sc + stash[(d * 16 + j) * 64 + lane];
        if (MODE == 0) write_gated(O, 1.f, C + tok * CP + C_G + hd * 64 + hf * 4);
        else if (O[0][0] + O[1][3] == 1.2345e-20f) C[tok * CP + CP - 1] = 0;
    }
}


#define XB_TMO      128
#define XB_XCNT(j)  (256  + 64 * (j))
#define XB_XSUB(j)  (1280 + 64 * (j))
#define XB_XGEN(j)  (2304 + 64 * (j))
#define XB_TOP      3328
#define XB_TOPGEN   3392
#define XCD_BAR_WORDS 3456
#define XB_SPIN_CAP (1u << 18)
DEV unsigned xb_ld(unsigned* p)              { return __hip_atomic_load(p, __ATOMIC_RELAXED, __HIP_MEMORY_SCOPE_AGENT); }
DEV unsigned xb_add(unsigned* p, unsigned v) { return __hip_atomic_fetch_add(p, v, __ATOMIC_RELAXED, __HIP_MEMORY_SCOPE_AGENT); }
DEV unsigned xb_xcc_id() { return (unsigned)__builtin_amdgcn_s_getreg((3 << 11) | 20) & 0xFu; }
#define XB_SPIN(cond, bar) do { unsigned _sp = 0; while (cond) { __builtin_amdgcn_s_sleep(1); \
    if ((++_sp & 255u) == 0u) { if (xb_ld(&(bar)[XB_TMO])) break; if (_sp > XB_SPIN_CAP) { atomicAdd(&(bar)[XB_TMO], 1u); break; } } } } while (0)
struct XcdBarrier { unsigned* bar; unsigned x; volatile LAS unsigned* st; };
DEV XcdBarrier xcd_barrier_post(unsigned* bar, volatile LAS unsigned* st) {
    XcdBarrier b; b.bar = bar; b.x = xb_xcc_id(); b.st = st;
    if (threadIdx.x == 0) (void)xb_add(&bar[XB_XCNT(b.x)], 1u);
    return b;
}
DEV void xcd_barrier_complete(unsigned* bar, unsigned x, unsigned& nloc, unsigned& nx) {
    const unsigned G = gridDim.x * gridDim.y * gridDim.z;
    unsigned sum, cnt, mine, sp = 0u;
    for (;;) {
        sum = 0u; cnt = 0u; mine = 0u;
#pragma unroll
        for (unsigned j = 0; j < 16; ++j) { const unsigned c = xb_ld(&bar[XB_XCNT(j)]); sum += c; cnt += (c > 0u) ? 1u : 0u; mine = (j == x) ? c : mine; }
        if (sum == G) break;
        __builtin_amdgcn_s_sleep(1);
        if ((++sp & 255u) == 0u) { if (xb_ld(&bar[XB_TMO])) break; if (sp > XB_SPIN_CAP) { atomicAdd(&bar[XB_TMO], 1u); break; } }
    }
    nloc = mine > 0u ? mine : 1u; nx = cnt > 0u ? cnt : 1u;
}
DEV void xcd_barrier(const XcdBarrier& b) {
    asm volatile("s_waitcnt vmcnt(0)" ::: "memory");
    __syncthreads();
    if (threadIdx.x == 0) {
        unsigned* bar = b.bar;
        __builtin_amdgcn_s_waitcnt(0);
        unsigned nloc = b.st[0], nx = b.st[1];
        if (nloc == 0u) { xcd_barrier_complete(bar, b.x, nloc, nx); b.st[0] = nloc; b.st[1] = nx; }
        const unsigned old = xb_add(&bar[XB_XSUB(b.x)], 1u);
        const unsigned gen = old / nloc;
        if (old + 1u == (gen + 1u) * nloc) {
            __builtin_amdgcn_fence(__ATOMIC_RELEASE, "agent");
            asm volatile("s_waitcnt vmcnt(0)" ::: "memory");
            const unsigned og = xb_add(&bar[XB_TOP], 1u);
            const unsigned tg = og / nx;
            if (og + 1u == (tg + 1u) * nx) xb_add(&bar[XB_TOPGEN], 1u);
            else XB_SPIN(xb_ld(&bar[XB_TOPGEN]) == tg, bar);
            __builtin_amdgcn_fence(__ATOMIC_ACQUIRE, "agent");
            xb_add(&bar[XB_XGEN(b.x)], 1u);
            asm volatile("s_waitcnt vmcnt(0)" ::: "memory");
        } else {
            XB_SPIN(xb_ld(&bar[XB_XGEN(b.x)]) == gen, bar);
            __builtin_amdgcn_fence(__ATOMIC_ACQUIRE, "agent");
            asm volatile("s_waitcnt vmcnt(0)" ::: "memory");
        }
    }
    __syncthreads();
}

#define FRESH() int tid = threadIdx.x; asm volatile("" : "+v"(tid)); size_t zoff_ = 0; asm volatile("" : "+s"(zoff_)); unsigned char* ws = p.ws + zoff_; \
    const int lane = tid & 63, wv = __builtin_amdgcn_readfirstlane(tid >> 6), gw = cb * 8 + wv; (void)lane; (void)gw; (void)ws;
__global__ void __launch_bounds__(512, 2) mega(Params p) {
    extern __shared__ __attribute__((aligned(16))) unsigned char smem[];
    cg::grid_group grid = cg::this_grid();
    LAS unsigned char* lds = (LAS unsigned char*)smem;
    const int G = gridDim.x, cb = blockIdx.x, nW = G * 8;
    volatile LAS unsigned* xst = (volatile LAS unsigned*)(lds + LDS_RING);
    if (threadIdx.x == 0) { xst[0] = 0u; xst[1] = 0u; }
    __syncthreads();
    const XcdBarrier xb = xcd_barrier_post((unsigned*)(p.ws + WS_BAR), xst);
    for (int ph = p.ph_lo; ph < p.ph_hi; ++ph) {
        if (ph > p.ph_lo) xcd_barrier(xb);
        if (p.ph_hi < 0) grid.sync();
        const int l = (ph >= 7) ? 1 : 0;
        const int lp = (ph == 0) ? 0 : (ph <= 5 ? ph : (ph == 6 ? 0 : (ph <= 11 ? ph - 6 : 12)));
        const size_t wlo = (size_t)l * W_LAYER;
#ifdef DBL_MASK
        const int reps = (((DBL_MASK) >> lp) & 1) ? 2 : 1;
#else
        const int reps = 1;
#endif
        for (int rep = 0; rep < reps; ++rep) {
        if (ph == 0) {
            { FRESH(); for (int i = cb; i < 2 * TJ_LAYER; i += G) { TJob j; make_tjob(p, ws, i, j); transpose_tile(j, (LAS float*)lds, tid); } }
            { FRESH(); rmsnorm_rows_bf16(p.in[0], p.in[1], (bf16_t*)(ws + WS_H), gw, nW, lane); }
        } else if (ph == 6) {
            FRESH(); rmsnorm_rows_bf16(p.out, p.in[1] + 1024, (bf16_t*)(ws + WS_H), gw, nW, lane);
        } else if (lp == 12) {
            FRESH(); rmsnorm_rows_f32(p.out, p.in[16], gw, nW, lane);
        } else if (lp == 1) {
            FRESH();
            pg8::SchedIn Sd{(const char*)(ws + WS_H), (const char*)(ws + wlo + W_IN), G, cb};
            pg8::EpiIn E{(bf16_t*)(ws + WS_C)};
            pg8::gemm_phase(lds, Sd, E, tid);
        } else if (lp == 2) {
#ifndef SK_CMP
            { FRESH(); for (int i = G - 1 - cb; i < 128; i += G) compress_item(p, ws, l, i, (LAS float*)lds, tid); }
#endif
#ifndef SK_Q
            { FRESH(); for (int i = gw; i < 1024; i += nW) mla_q_item((const bf16_t*)(ws + WS_C), p.in[3] + l * 192, (const bf16_t*)(ws + wlo + W_UQ), (bf16_t*)(ws + R_QB), i, lane); }
#endif
#ifndef SK_KV
            { FRESH(); for (int i = nW - 1 - gw; i < 1024; i += nW) mla_kv_item((const bf16_t*)(ws + WS_C), p.in[5] + l * 128, (const bf16_t*)(ws + wlo + W_UKV), (bf16_t*)(ws + R_KB), (bf16_t*)(ws + R_VTB), i, lane); }
#endif
#ifndef SK_VT
            { FRESH(); const bf16_t* C = (const bf16_t*)(ws + WS_C);
            for (int i = gw; i < 3 * 16 * 256 + 16 * 128 + 4 * 4 * 256 + 16 * 256; i += nW) {
                if (i < 3 * 16 * 256) {
                    const int kind = i >> 12, bh = (i >> 8) & 15, tl = i & 255; const int b = bh >> 2, h = bh & 3;
                    const bf16_t* src = C + (size_t)b * S * CP + A_V + h * 64;
                    bf16_t* dst = (bf16_t*)(ws + (kind == 0 ? R_VTA1 : kind == 1 ? R_VTA4 : R_VTA16)) + ((size_t)bh * 256 + tl) * 2048;
                    if (kind == 0) vfrag_item(src, tl * 32, 1, dst, lane);
                    else if (kind == 1) { const int r4 = tl >> 6, u0 = (tl & 63) * 32; vfrag_item(src, r4 + 4 * u0, 4, dst, lane); }
                    else { const int r16 = tl >> 4, u0 = (tl & 15) * 32; vfrag_item(src, r16 + 16 * u0, 16, dst, lane); }
                } else if (i < 3 * 16 * 256 + 16 * 128) {
                    const int k = i - 3 * 16 * 256; const int bh = k >> 7, tl = k & 127; const int b = bh >> 2, h = bh & 3;
                    vtrans_item(C + (size_t)b * S * CP + D_V + h * 64, tl * 64, 1, (bf16_t*)(ws + R_VTD) + (size_t)bh * 64 * S + tl * 64, S, lane);
                } else if (i >= 3 * 16 * 256 + 16 * 128 + 4 * 4 * 256) {
                    const int k = i - (3 * 16 * 256 + 16 * 128 + 4 * 4 * 256); const int bh = k >> 8, tl = k & 255;
                    kfrag_item(C + (size_t)(bh >> 2) * S * CP + A_K + (bh & 3) * 64, tl * 32, (bf16_t*)(ws + R_KFA1) + ((size_t)bh * 256 + tl) * 2048, lane);
                } else {
                    const int k = i - (3 * 16 * 256 + 16 * 128); const int kind = k >> 10, b = (k >> 8) & 3, tl = k & 255;
                    const bf16_t* src = C + (size_t)b * S * CP + (kind == 0 ? C_VS : kind == 1 ? C_VW : kind == 2 ? C_KS : C_KW);
                    bf16_t* dst = (bf16_t*)(ws + (kind == 0 ? R_VTCS : kind == 1 ? R_VTCW : kind == 2 ? R_KFCS : R_KFCW)) + ((size_t)b * 256 + tl) * 2048;
                    if (kind < 2) vfrag_item(src, tl * 32, 1, dst, lane); else kfrag_item(src, tl * 32, dst, lane);
                }
            } }
#endif
        } else if (lp == 3) {
#ifndef SK_MLA
            { FRESH(); for (int k = 0; k * G < 512; ++k) { const int g = k * G + ((k & 1) ? G - 1 - cb : cb); if (g >= 512) continue;
                const int qt8 = 31 - (g >> 4), bh = g & 15;
#ifdef EXP_MLA
                mla_item<EXP_MLA>(ws, bh >> 2, bh & 3, qt8 * 8 + wv, lane, lds + wv * 16384);
#endif
                mla_item(ws, bh >> 2, bh & 3, qt8 * 8 + wv, lane, lds + wv * 16384); } }
#endif
#ifndef SK_NSA
            { FRESH(); for (int k = 0; k * G < 512; ++k) { const int g = k * G + ((k & 1) ? G - 1 - cb : cb); if (g >= 512) continue;
                const int qg = 127 - (g >> 2), b = g & 3; LAS float* As = (LAS float*)lds + wv * 4096;
#ifdef EXP_NSA
                nsa_item<EXP_NSA>(ws, b, qg * 64 + wv * 8, lane, As, As + 1024, As + 2048);
#endif
                nsa_item(ws, b, qg * 64 + wv * 8, lane, As, As + 1024, As + 2048); } }
#endif
#ifndef SK_DSW
            { FRESH(); for (int k = 0; k * G < 512; ++k) { const int g = k * G + ((k & 1) ? G - 1 - cb : cb); if (g >= 512) continue;
                const int bh = g & 15, ut = (g >> 4) & 15, oc = g >> 8;
#ifdef EXP_DSW
                dsw_item<1>(ws, bh >> 2, bh & 3, oc * 8 + wv, ut, lane);
#endif
                dsw_item(ws, bh >> 2, bh & 3, oc * 8 + wv, ut, lane); } }
#endif
#ifndef SK_SB
            { FRESH(); for (int k = 0; k * G < 512; ++k) { const int g = k * G + ((k & 1) ? G - 1 - cb : cb); if (g >= 512) continue;
                const int qt8 = 31 - (g >> 4), bh = g & 15;
#ifdef EXP_SB
                sb_item<1>(ws, bh >> 2, bh & 3, qt8 * 8 + wv, lane);
#endif
                sb_item(ws, bh >> 2, bh & 3, qt8 * 8 + wv, lane); } }
#endif
        } else if (lp == 4) {
            FRESH();
            pg8::SchedMerge Sd{(const char*)(ws + WS_H), (const char*)(ws + WS_C), (const char*)(ws + wlo + W_MG), (const char*)(ws + wlo + W_BR), G, cb};
            pg8::EpiMerge E{p.in[14] + (size_t)l * 4096, (bf16_t*)(ws + R_GS) + (size_t)cb * 65536, (bf16_t*)(ws + R_MACC) + (size_t)cb * 65536, (bf16_t*)(ws + R_MB)};
            pg8::gemm_phase(lds, Sd, E, tid);
        } else if (lp == 5) {
            FRESH();
            pg8::SchedOut Sd{(const char*)(ws + R_MB), (const char*)(ws + wlo + W_OUT), G, cb};
            pg8::EpiOut E{l == 0 ? p.in[0] : (const float*)p.out, p.out};
            pg8::gemm_phase(lds, Sd, E, tid);
        }
        __syncthreads();
        }
    }
#ifdef DBG_K
    {
        asm volatile("s_waitcnt vmcnt(0) lgkmcnt(0)" ::: "memory");
        __syncthreads();
        if (threadIdx.x < 64) { __builtin_amdgcn_fence(__ATOMIC_RELEASE, "agent"); asm volatile("s_waitcnt vmcnt(0)" ::: "memory"); }
        grid.sync();
        __builtin_amdgcn_fence(__ATOMIC_ACQUIRE, "agent"); asm volatile("s_waitcnt vmcnt(0)" ::: "memory");
        const bf16_t* src = (const bf16_t*)(p.ws + DBG_OFF);
        const size_t nel = (size_t)(DBG_BYTES) / 2, NO = (size_t)T * 1024;
        for (size_t i = (size_t)blockIdx.x * 512 + threadIdx.x; i < NO; i += (size_t)gridDim.x * 512) {
            float s = 0.f;
            for (size_t k = i; k < nel; k += NO) s += bf2f(src[k]);
            p.out[i] = s;
        }
    }
#endif
}

extern "C" void kernel_launch(void* const* d_in, const int* in_sizes, int n_in, void* d_out, int out_size, void* d_ws, size_t ws_size, hipStream_t stream) {
    static int grid_blocks = 0;
    if (!grid_blocks) {
        if (hipFuncSetAttribute((const void*)mega, hipFuncAttributeMaxDynamicSharedMemorySize, LDS_BYTES) != hipSuccess) { fprintf(stderr, "hipFuncSetAttribute failed\n"); return; }
        int dev = 0, cus = 0, per_cu = 0;
        hipGetDevice(&dev);
        hipDeviceGetAttribute(&cus, hipDeviceAttributeMultiprocessorCount, dev);
        hipOccupancyMaxActiveBlocksPerMultiprocessor(&per_cu, mega, 512, LDS_BYTES);
        if (per_cu < 1) { fprintf(stderr, "occupancy query returned %d\n", per_cu); return; }
        grid_blocks = cus;
        if (grid_blocks > 256) grid_blocks = 256;
    }
    if (ws_size < WS_TOTAL) { fprintf(stderr, "workspace too small: %zu < %zu\n", ws_size, (size_t)WS_TOTAL); return; }
    (void)hipMemsetAsync((unsigned char*)d_ws + WS_BAR, 0, 16384, stream);
    Params p{};
    for (int i = 0; i < 17; ++i) p.in[i] = (const float*)d_in[i];
#ifdef DBG_K
    p.out = (float*)d_out; p.ws = (unsigned char*)d_ws; p.ph_lo = 0; p.ph_hi = DBG_K;
#else
    p.out = (float*)d_out; p.ws = (unsigned char*)d_ws; p.ph_lo = 0; p.ph_hi = 13;
#endif
    void* args[] = {&p};
    hipError_t e = hipLaunchCooperativeKernel((const void*)mega, dim3(grid_blocks), dim3(512), args, LDS_BYTES, stream);
    if (e != hipSuccess) fprintf(stderr, "cooperative launch failed: %s (grid %d)\n", hipGetErrorString(e), grid_blocks);
}
```

```cpp
#include <hip/hip_runtime.h>
#include <hip/hip_cooperative_groups.h>
#include <cstdio>
#include <cstdint>
namespace cg = cooperative_groups;

#define LAS __attribute__((address_space(3)))
#define DEV __device__ __forceinline__
typedef unsigned short bf16_t;
typedef short bf16x8 __attribute__((ext_vector_type(8)));
typedef short s16x4 __attribute__((ext_vector_type(4)));
typedef float f32x2 __attribute__((ext_vector_type(2)));
typedef float f32x4 __attribute__((ext_vector_type(4)));
typedef float f32x16 __attribute__((ext_vector_type(16)));
typedef unsigned u32x2 __attribute__((ext_vector_type(2)));
typedef unsigned u32x4 __attribute__((ext_vector_type(4)));

constexpr int NB = 4, S = 8192, T = NB * S, DM = 1024, CP = 3584;
constexpr int A_Q = 0, A_K = 256, A_V = 512, A_G = 768, B_G = 1024, C_Q = 1280, C_G = 1536, D_Q = 1792, D_K = 2048, D_V = 2304, D_G = 2560,
              B_CQ = 2816, B_CKV = 3008, B_KPE = 3136, C_KC = 3168, C_VC = 3232, C_KS = 3296, C_VS = 3360, C_KW = 3424, C_VW = 3488, C_GT = 3552;
constexpr float LOG2E = 1.44269504088896f;
constexpr float NEG = -1e30f;

constexpr size_t W_IN = 0, W_MG = W_IN + (size_t)CP * 1024 * 2, W_BR = W_MG + (size_t)4096 * 1024 * 2, W_OUT = W_BR + (size_t)4096 * 256 * 2,
                 W_UQ = W_OUT + (size_t)1024 * 1024 * 2, W_UKV = W_UQ + (size_t)384 * 192 * 2, W_W1 = W_UKV + (size_t)512 * 128 * 2,
                 W_W2 = W_W1 + (size_t)2 * 128 * 2048 * 2, W_LAYER = W_W2 + (size_t)2 * 64 * 128 * 2;
constexpr size_t WS_H = 2 * W_LAYER, WS_C = WS_H + (size_t)T * 1024 * 2, WS_R = WS_C + (size_t)T * CP * 2;
constexpr size_t R_QB = WS_R, R_KB = R_QB + (size_t)T * 384 * 2, R_VTB = R_KB + (size_t)T * 384 * 2, R_VTD = R_VTB + (size_t)T * 256 * 2,
                 R_VTA1 = R_VTD + (size_t)T * 256 * 2, R_VTA4 = R_VTA1 + (size_t)T * 256 * 2, R_VTA16 = R_VTA4 + (size_t)T * 256 * 2,
                 R_VTCS = R_VTA16 + (size_t)T * 256 * 2, R_VTCW = R_VTCS + (size_t)T * 64 * 2, R_KCMP = R_VTCW + (size_t)T * 64 * 2,
                 R_VTCMP = R_KCMP + (size_t)NB * 512 * 64 * 2, R_KFCS = R_VTCMP + (size_t)NB * 512 * 64 * 2, R_KFCW = R_KFCS + (size_t)T * 64 * 2, R_KFA1 = R_KFCW + (size_t)T * 64 * 2, R_END1 = R_KFA1 + (size_t)T * 256 * 2;
constexpr size_t R_MB = WS_R, R_GS = R_MB + (size_t)T * 1024 * 2, R_MACC = R_GS + (size_t)256 * 65536 * 2, R_END2 = R_MACC + (size_t)256 * 65536 * 2;
constexpr size_t WS_NEED = (R_END1 > R_END2 ? R_END1 : R_END2);
constexpr size_t WS_BAR = (WS_NEED + 255) & ~(size_t)255, WS_TOTAL = WS_BAR + 16384;
constexpr int LDS_RING = 131072, LDS_BYTES = LDS_RING + 64;

struct Params { const float* in[17]; float* out; unsigned char* ws; int ph_lo, ph_hi; };

DEV float ex2(float x) { return __builtin_amdgcn_exp2f(x); }
DEV float lg2(float x) { return __builtin_amdgcn_logf(x); }
DEV float rcp(float x) { return __builtin_amdgcn_rcpf(x); }
DEV float sigm(float x) { return rcp(1.f + ex2(-LOG2E * x)); }
typedef __bf16 bf16x2_t __attribute__((ext_vector_type(2)));
DEV unsigned pk2(float lo, float hi) { const f32x2 v = {lo, hi}; const bf16x2_t b = __builtin_convertvector(v, bf16x2_t); return __builtin_bit_cast(unsigned, b); }
DEV float bflo(unsigned u) { return __builtin_bit_cast(float, u << 16); }
DEV float bfhi(unsigned u) { return __builtin_bit_cast(float, u & 0xffff0000u); }
DEV float bf2f(bf16_t v) { return __builtin_bit_cast(float, (unsigned)v << 16); }
DEV void xhalf_pair(float x, float& a, float& b) {
    a = x;
    asm volatile("v_mov_b32 %1, %0\n\ts_nop 1\n\tv_permlane32_swap_b32 %0, %1\n\ts_nop 1" : "+v"(a), "=&v"(b));
}
template <int CTRL> DEV float dpp_quad(float x) { return __builtin_bit_cast(float, __builtin_amdgcn_update_dpp(0, __builtin_bit_cast(int, x), CTRL, 0xF, 0xF, false)); }
DEV float xhalf_get(float x, int hf) { float a, b; xhalf_pair(x, a, b); return hf ? a : b; }
DEV float xhalf_max(float x) { float a, b; xhalf_pair(x, a, b); return fmaxf(a, b); }
DEV float xhalf_sum(float x) { float a, b; xhalf_pair(x, a, b); return a + b; }
DEV float wave_sum(float v) {
#pragma unroll
    for (int o = 32; o; o >>= 1) v += __shfl_xor(v, o);
    return v;
}
DEV bf16x8 pack8(float a0, float a1, float a2, float a3, float a4, float a5, float a6, float a7) {
    u32x4 w; w.x = pk2(a0, a1); w.y = pk2(a2, a3); w.z = pk2(a4, a5); w.w = pk2(a6, a7); return __builtin_bit_cast(bf16x8, w);
}
#define MFMA32(a, b, c) __builtin_amdgcn_mfma_f32_32x32x16_bf16((a), (b), (c), 0, 0, 0)
DEV f32x16 zero16() { f32x16 z;
#pragma unroll
    for (int j = 0; j < 16; ++j) z[j] = 0.f; return z; }
DEV int kap(int j, int hf) { return 8 * (j >> 2) + 4 * hf + (j & 3); }

DEV int orig_col(int n) {
    if (n < 1024) return n;
    if (n < 1280) return n - 1024 + 1376;
    if (n < 1536) return n - 1280 + 1632;
    if (n < 1792) return n - 1536 + 2284;
    if (n < 2048) return n - 1792 + 2540;
    if (n < 2304) return n - 2048 + 2796;
    if (n < 2560) return n - 2304 + 3052;
    if (n < 2816) return n - 2560 + 3308;
    if (n < 3008) return n - 2816 + 1024;
    if (n < 3136) return n - 3008 + 1216;
    if (n < 3168) return n - 3136 + 1344;
    if (n < 3552) return n - 3168 + 1888;
    if (n < 3564) return n - 3552 + 2272;
    return -1;
}

namespace pg8 {
constexpr int BM = 256, BK = 64, HALF = 128, HTB = HALF * BK * 2;
DEV int lds_byte(int r, int c) { const int st = (r >> 4) * 2 + (c >> 5), rr = r & 15, cc = c & 31, ob = rr * 64 + cc * 2; return st * 1024 + (ob ^ (((ob >> 9) & 1) << 5)); }
DEV void stage_rc(int b, int& R, int& C) { const int st = b / 1024, sb = b % 1024, swz = sb ^ (((sb >> 9) & 1) << 5); R = (st >> 1) * 16 + swz / 64; C = (st & 1) * 32 + (swz % 64) / 2; }
DEV int perm32(int rho) { const int n = rho >> 4, i = rho & 15; return 8 * (i >> 2) + 4 * n + (i & 3); }

struct GUnit { const char* A; const char* B; int lda2, ldb2, nt, kind, pm, pn; };

template <class Epi, class Sched>
DEV void gemm_phase(LAS unsigned char* lds, const Sched& S, const Epi& E, const int tid) {
    const int wid = __builtin_amdgcn_readfirstlane(tid >> 6), lane = tid & 63, wr = wid >> 2, wc = wid & 3, fr = lane & 15, fq = lane >> 4;
    int R0, C0; stage_rc(tid * 16, R0, C0);
    const int Rb0 = (R0 & ~31) + perm32(R0 & 31);
    const unsigned c2 = (unsigned)C0 * 2u;
    const unsigned ldsw = (unsigned)wid * 1024u;
    const int aoff = lds_byte(wr * 64 + fr, fq * 8), boff = lds_byte(wc * 32 + fr, fq * 8);
    const size_t kstep = (size_t)(BK * 2);
#define PG8_SA(b, h) (((b) * 2 + (h)) * HTB)
#define PG8_SB(b, h) ((4 + (b) * 2 + (h)) * HTB)
#define PG8_STAGE(bufoff, gbase, RR, ld2) do { _Pragma("unroll") for (int _i = 0; _i < 2; ++_i) \
        __builtin_amdgcn_global_load_lds((const unsigned*)((const char*)(gbase) + (size_t)((unsigned)((RR) + 64 * _i) * (unsigned)(ld2) + c2)), (LAS unsigned*)(lds + (bufoff) + ldsw + _i * 8192), 16, 0, 0); } while (0)
#define PG8_LDA(dst, b, h) do { _Pragma("unroll") for (int m = 0; m < 4; ++m) _Pragma("unroll") for (int k = 0; k < 2; ++k) dst[m][k] = *(const LAS bf16x8*)(lds + PG8_SA(b, h) + aoff + m * 2048 + k * 1024); } while (0)
#define PG8_LDB(dst, b, h) do { _Pragma("unroll") for (int n = 0; n < 2; ++n) _Pragma("unroll") for (int k = 0; k < 2; ++k) dst[n][k] = *(const LAS bf16x8*)(lds + PG8_SB(b, h) + boff + n * 2048 + k * 1024); } while (0)
#define PG8_MMA(ai, bj, At, Bt) do { __builtin_amdgcn_s_setprio(1); _Pragma("unroll") for (int m = 0; m < 4; ++m) _Pragma("unroll") for (int n = 0; n < 2; ++n) _Pragma("unroll") for (int k = 0; k < 2; ++k) \
        acc[ai][bj][m][n] = __builtin_amdgcn_mfma_f32_16x16x32_bf16(Bt[n][k], At[m][k], acc[ai][bj][m][n], 0, 0, 0); __builtin_amdgcn_s_setprio(0); } while (0)
#define PG8_WAIT_V(n) asm volatile("s_waitcnt vmcnt(" #n ")" ::: "memory")
#define PG8_WAIT_L(n) asm volatile("s_waitcnt lgkmcnt(" #n ")" ::: "memory")
#define PG8_BAR __builtin_amdgcn_s_barrier()
#define PG8_SCHED __builtin_amdgcn_sched_barrier(0)
    GUnit cur, nxt; int ui = 0;
    if (!S.next(0, cur)) return;
    f32x4 acc[2][2][4][2];
#pragma unroll
    for (int a = 0; a < 2; ++a)
#pragma unroll
        for (int b = 0; b < 2; ++b)
#pragma unroll
            for (int m = 0; m < 4; ++m)
#pragma unroll
                for (int n = 0; n < 2; ++n) acc[a][b][m][n] = (f32x4){0.f, 0.f, 0.f, 0.f};
    bf16x8 At[4][2], B0[2][2], B1[2][2];
    const char* cA = cur.A; const char* cB = cur.B; int clda = cur.lda2, cldb = cur.ldb2;
    {
        const size_t chA = (size_t)HALF * clda, chB = (size_t)HALF * cldb;
        PG8_STAGE(PG8_SB(0, 0), cB, Rb0, cldb); PG8_STAGE(PG8_SB(0, 1), cB + chB, Rb0, cldb); PG8_STAGE(PG8_SA(0, 0), cA, R0, clda); PG8_STAGE(PG8_SA(0, 1), cA + chA, R0, clda);
        if (wr == 1) PG8_BAR;
        PG8_WAIT_V(2); PG8_BAR;
        PG8_STAGE(PG8_SB(1, 0), cB + kstep, Rb0, cldb); PG8_STAGE(PG8_SA(1, 0), cA + kstep, R0, clda); PG8_STAGE(PG8_SB(1, 1), cB + chB + kstep, Rb0, cldb);
        PG8_WAIT_V(6); PG8_BAR;
    }
    for (;;) {
        const bool has_next = S.next(ui + 1, nxt);
        const char* nA = has_next ? nxt.A : cA; const char* nB = has_next ? nxt.B : cB;
        const int nlda = has_next ? nxt.lda2 : clda, nldb = has_next ? nxt.ldb2 : cldb;
        const int nt = cur.nt;
        const size_t chA = (size_t)HALF * clda;
        for (int t = 0; t < nt; t += 2) {
            const bool last = (t == nt - 2);
            const char* a1 = cA + (size_t)(t + 1) * kstep;
            const char* a2 = last ? nA : cA + (size_t)(t + 2) * kstep; const char* b2 = last ? nB : cB + (size_t)(t + 2) * kstep;
            const int l2a = last ? nlda : clda, l2b = last ? nldb : cldb;
            const size_t h2a = (size_t)HALF * l2a, h2b = (size_t)HALF * l2b;
            const char* a3 = a2 + kstep; const char* b3 = b2 + kstep;
            PG8_LDB(B0, 0, 0); PG8_LDB(B1, 0, 1); PG8_SCHED; PG8_LDA(At, 0, 0); PG8_STAGE(PG8_SA(1, 1), a1 + chA, R0, clda);
            PG8_WAIT_V(8); PG8_WAIT_L(0); PG8_BAR; PG8_MMA(0, 0, At, B0); PG8_MMA(0, 1, At, B1); PG8_BAR; PG8_SCHED;
            PG8_LDA(At, 0, 1); PG8_STAGE(PG8_SB(0, 0), b2, Rb0, l2b); PG8_STAGE(PG8_SB(0, 1), b2 + h2b, Rb0, l2b); PG8_STAGE(PG8_SA(0, 0), a2, R0, l2a);
            PG8_WAIT_V(8); PG8_WAIT_L(0); PG8_BAR; PG8_MMA(1, 0, At, B0); PG8_MMA(1, 1, At, B1); PG8_BAR; PG8_SCHED;
            PG8_LDB(B0, 1, 0); PG8_LDB(B1, 1, 1); PG8_SCHED; PG8_LDA(At, 1, 0); PG8_STAGE(PG8_SA(0, 1), a2 + h2a, R0, l2a);
            PG8_WAIT_V(8); PG8_WAIT_L(0); PG8_BAR; PG8_MMA(0, 0, At, B0); PG8_MMA(0, 1, At, B1); PG8_BAR; PG8_SCHED;
            PG8_LDA(At, 1, 1); PG8_STAGE(PG8_SB(1, 0), b3, Rb0, l2b); PG8_STAGE(PG8_SB(1, 1), b3 + h2b, Rb0, l2b); PG8_STAGE(PG8_SA(1, 0), a3, R0, l2a);
            PG8_WAIT_V(8); PG8_WAIT_L(0); PG8_BAR; PG8_MMA(1, 0, At, B0); PG8_MMA(1, 1, At, B1); PG8_BAR; PG8_SCHED;
        }
        if (wr == 0) PG8_BAR;
        E(acc, cur, wr, wc, fr, fq);
        if (!has_next) break;
#pragma unroll
        for (int a = 0; a < 2; ++a)
#pragma unroll
            for (int b = 0; b < 2; ++b)
#pragma unroll
                for (int m = 0; m < 4; ++m)
#pragma unroll
                    for (int n = 0; n < 2; ++n) acc[a][b][m][n] = (f32x4){0.f, 0.f, 0.f, 0.f};
        cur = nxt; cA = nA; cB = nB; clda = nlda; cldb = nldb; ++ui;
        if (wr == 1) PG8_BAR;
    }
    PG8_WAIT_V(0);
    PG8_BAR;
#undef PG8_SA
#undef PG8_SB
#undef PG8_STAGE
#undef PG8_LDA
#undef PG8_LDB
#undef PG8_MMA
#undef PG8_WAIT_V
#undef PG8_WAIT_L
#undef PG8_BAR
#undef PG8_SCHED
}

struct SchedIn {
    const char* H; const char* W; int G, c;
    DEV bool next(int i, GUnit& u) const {
        const int L = i * G + c; if (L >= 128 * 14) return false;
        u.pm = L & 127; u.pn = L >> 7; u.kind = 0; u.nt = 16; u.lda2 = 2048; u.ldb2 = 2048;
        u.A = H + (size_t)u.pm * 256 * 2048; u.B = W + (size_t)u.pn * 256 * 2048; return true;
    }
};
struct SchedMerge {
    const char* H; const char* Cb; const char* WMG; const char* WBR; int G, c;
    DEV bool next(int i, GUnit& u) const {
        const int p = i >> 3, st = i & 7; const int L = p * G + c; if (L >= 512) return false;
        u.pm = (L & 7) | ((L >> 5) << 3); u.pn = (L >> 3) & 3; u.kind = st; const int br = st >> 1;
        if (!(st & 1)) { u.A = H + (size_t)u.pm * 256 * 2048; u.lda2 = 2048; u.B = WMG + (size_t)(br * 1024 + u.pn * 256) * 2048; u.ldb2 = 2048; u.nt = 16; }
        else { const int gc = br == 0 ? A_G : br == 1 ? B_G : br == 2 ? C_G : D_G;
               u.A = Cb + ((size_t)u.pm * 256 * CP + gc) * 2; u.lda2 = CP * 2; u.B = WBR + (size_t)(br * 1024 + u.pn * 256) * 512; u.ldb2 = 512; u.nt = 4; }
        return true;
    }
};
struct SchedOut {
    const char* Mb; const char* W; int G, c;
    DEV bool next(int i, GUnit& u) const {
        const int L = i * G + c; if (L >= 512) return false;
        u.pm = (L & 7) | ((L >> 5) << 3); u.pn = (L >> 3) & 3; u.kind = 0; u.nt = 16; u.lda2 = 2048; u.ldb2 = 2048;
        u.A = Mb + (size_t)u.pm * 256 * 2048; u.B = W + (size_t)u.pn * 256 * 2048; return true;
    }
};

struct EpiIn {
    bf16_t* C;
    DEV void operator()(const f32x4 (&acc)[2][2][4][2], const GUnit& u, int wr, int wc, int fr, int fq) const {
        const int row0 = u.pm * BM + wr * 64 + fr, col0 = u.pn * BM + wc * 32 + 8 * fq;
#pragma unroll
        for (int ai = 0; ai < 2; ++ai)
#pragma unroll
            for (int m = 0; m < 4; ++m) { bf16_t* rowp = C + (size_t)(row0 + ai * HALF + m * 16) * CP + col0;
#pragma unroll
                for (int bj = 0; bj < 2; ++bj) { const f32x4 v0 = acc[ai][bj][m][0], v1 = acc[ai][bj][m][1];
                    u32x4 w; w.x = pk2(v0[0], v0[1]); w.y = pk2(v0[2], v0[3]); w.z = pk2(v1[0], v1[1]); w.w = pk2(v1[2], v1[3]);
                    *(u32x4*)(rowp + bj * HALF) = w; } }
    }
};
struct EpiMerge {
    const float* bm;
    bf16_t* Gs; bf16_t* Macc; bf16_t* Mb;
    DEV void operator()(const f32x4 (&acc)[2][2][4][2], const GUnit& u, int wr, int wc, int fr, int fq) const {
        const int br = u.kind >> 1;
        int rr0 = wr * 64 + fr, cc0 = wc * 32 + 8 * fq;
        asm volatile("" : "+v"(rr0), "+v"(cc0));
        if (!(u.kind & 1)) {
            f32x4 bv[2][2];
#pragma unroll
            for (int bj = 0; bj < 2; ++bj)
#pragma unroll
                for (int n = 0; n < 2; ++n) bv[bj][n] = *(const f32x4*)(bm + br * 1024 + u.pn * 256 + cc0 + bj * HALF + 4 * n);
#pragma unroll
            for (int ai = 0; ai < 2; ++ai)
#pragma unroll
                for (int m = 0; m < 4; ++m) { const int rr = rr0 + ai * HALF + m * 16;
#pragma unroll
                    for (int bj = 0; bj < 2; ++bj) { const f32x4 v0 = acc[ai][bj][m][0] + bv[bj][0], v1 = acc[ai][bj][m][1] + bv[bj][1];
                        u32x4 w; w.x = pk2(sigm(v0[0]), sigm(v0[1])); w.y = pk2(sigm(v0[2]), sigm(v0[3])); w.z = pk2(sigm(v1[0]), sigm(v1[1])); w.w = pk2(sigm(v1[2]), sigm(v1[3]));
                        *(u32x4*)(Gs + rr * 256 + cc0 + bj * HALF) = w; } }
        } else {
#pragma unroll
            for (int ai = 0; ai < 2; ++ai)
#pragma unroll
                for (int bj = 0; bj < 2; ++bj) {
                    const int idx0 = (rr0 + ai * HALF) * 256 + cc0 + bj * HALF;
                    u32x4 g[4], mc[4];
#pragma unroll
                    for (int m = 0; m < 4; ++m) g[m] = __builtin_nontemporal_load((const u32x4*)(Gs + idx0 + m * 4096));
                    if (br > 0) {
#pragma unroll
                        for (int m = 0; m < 4; ++m) mc[m] = __builtin_nontemporal_load((const u32x4*)(Macc + idx0 + m * 4096));
                    }
#pragma unroll
                    for (int m = 0; m < 4; ++m) { const int idx = idx0 + m * 4096;
                        f32x4 v0 = acc[ai][bj][m][0], v1 = acc[ai][bj][m][1];
                        v0[0] *= bflo(g[m].x); v0[1] *= bfhi(g[m].x); v0[2] *= bflo(g[m].y); v0[3] *= bfhi(g[m].y);
                        v1[0] *= bflo(g[m].z); v1[1] *= bfhi(g[m].z); v1[2] *= bflo(g[m].w); v1[3] *= bfhi(g[m].w);
                        if (br > 0) { v0[0] += bflo(mc[m].x); v0[1] += bfhi(mc[m].x); v0[2] += bflo(mc[m].y); v0[3] += bfhi(mc[m].y);
                                      v1[0] += bflo(mc[m].z); v1[1] += bfhi(mc[m].z); v1[2] += bflo(mc[m].w); v1[3] += bfhi(mc[m].w); }
                        u32x4 w; w.x = pk2(v0[0], v0[1]); w.y = pk2(v0[2], v0[3]); w.z = pk2(v1[0], v1[1]); w.w = pk2(v1[2], v1[3]);
                        if (br < 3) *(u32x4*)(Macc + idx) = w;
                        else { *(u32x4*)(Mb + (size_t)(u.pm * BM + rr0 + ai * HALF + m * 16) * 1024 + u.pn * BM + cc0 + bj * HALF) = w; } }
                }
        }
    }
};
struct EpiOut {
    const float* xin; float* xout;
    DEV void operator()(const f32x4 (&acc)[2][2][4][2], const GUnit& u, int wr, int wc, int fr, int fq) const {
        const int row0 = u.pm * BM + wr * 64 + fr, col0 = u.pn * BM + wc * 32 + 8 * fq;
#pragma unroll
        for (int ai = 0; ai < 2; ++ai)
#pragma unroll
            for (int m = 0; m < 4; ++m) { const size_t ro = (size_t)(row0 + ai * HALF + m * 16) * 1024 + col0;
#pragma unroll
                for (int bj = 0; bj < 2; ++bj) { const size_t o = ro + bj * HALF;
                    const f32x4 x0 = *(const f32x4*)(xin + o), x1 = *(const f32x4*)(xin + o + 4);
                    *(f32x4*)(xout + o) = x0 + acc[ai][bj][m][0]; *(f32x4*)(xout + o + 4) = x1 + acc[ai][bj][m][1]; } }
    }
};
}

struct TJob { const float* src; int srcld; int mode; bf16_t* dst; int K; int n0, k0; };
DEV void transpose_tile(const TJob& j, LAS float* tile, const int tid) {
    { const int nl = tid & 63, kr = tid >> 6; const int n = j.n0 + nl; const int col = j.mode ? orig_col(n) : n;
#pragma unroll
      for (int ps = 0; ps < 8; ++ps) { const int k = ps * 8 + kr; tile[k * 65 + nl] = (col >= 0) ? j.src[(size_t)(j.k0 + k) * j.srcld + col] : 0.f; } }
    __syncthreads();
    { const int kk = (tid & 31) * 2, nr = tid >> 5;
#pragma unroll
      for (int ps = 0; ps < 4; ++ps) { const int nn = ps * 16 + nr; *(unsigned*)(j.dst + (size_t)(j.n0 + nn) * j.K + j.k0 + kk) = pk2(tile[kk * 65 + nn], tile[(kk + 1) * 65 + nn]); } }
    __syncthreads();
}
constexpr int TJ_IN = 56 * 16, TJ_MG = 4 * 256, TJ_BR = 4 * 64, TJ_OUT = 256, TJ_UQ = 18, TJ_UKV = 16, TJ_W1 = 128, TJ_W2 = 4;
constexpr int TJ_LAYER = TJ_IN + TJ_MG + TJ_BR + TJ_OUT + TJ_UQ + TJ_UKV + TJ_W1 + TJ_W2;
DEV void make_tjob(const Params& p, unsigned char* ws, int idx, TJob& j) {
    const int l = idx / TJ_LAYER; int i = idx % TJ_LAYER;
    unsigned char* wl = ws + (size_t)l * W_LAYER;
    j.mode = 0;
    if (i < TJ_IN) { j.src = p.in[2] + (size_t)l * 1024 * 3564; j.srcld = 3564; j.mode = 1; j.dst = (bf16_t*)(wl + W_IN); j.K = 1024; j.n0 = (i / 16) * 64; j.k0 = (i % 16) * 64; return; }
    i -= TJ_IN;
    if (i < TJ_MG) { const int b = i >> 8, r = i & 255; j.src = p.in[13] + (size_t)(l * 4 + b) * 1024 * 1024; j.srcld = 1024; j.dst = (bf16_t*)(wl + W_MG) + (size_t)b * 1024 * 1024; j.K = 1024; j.n0 = (r >> 4) * 64; j.k0 = (r & 15) * 64; return; }
    i -= TJ_MG;
    if (i < TJ_BR) { const int b = i >> 6, r = i & 63; j.src = p.in[12] + (size_t)(l * 4 + b) * 256 * 1024; j.srcld = 1024; j.dst = (bf16_t*)(wl + W_BR) + (size_t)b * 1024 * 256; j.K = 256; j.n0 = (r >> 2) * 64; j.k0 = (r & 3) * 64; return; }
    i -= TJ_BR;
    if (i < TJ_OUT) { j.src = p.in[15] + (size_t)l * 1024 * 1024; j.srcld = 1024; j.dst = (bf16_t*)(wl + W_OUT); j.K = 1024; j.n0 = (i >> 4) * 64; j.k0 = (i & 15) * 64; return; }
    i -= TJ_OUT;
    if (i < TJ_UQ) { j.src = p.in[4] + (size_t)l * 192 * 384; j.srcld = 384; j.dst = (bf16_t*)(wl + W_UQ); j.K = 192; j.n0 = (i / 3) * 64; j.k0 = (i % 3) * 64; return; }
    i -= TJ_UQ;
    if (i < TJ_UKV) { j.src = p.in[6] + (size_t)l * 128 * 512; j.srcld = 512; j.dst = (bf16_t*)(wl + W_UKV); j.K = 128; j.n0 = (i >> 1) * 64; j.k0 = (i & 1) * 64; return; }
    i -= TJ_UKV;
    if (i < TJ_W1) { const int b = i >> 6, r = i & 63; j.src = p.in[8] + (size_t)(l * 2 + b) * 2048 * 128; j.srcld = 128; j.dst = (bf16_t*)(wl + W_W1) + (size_t)b * 128 * 2048; j.K = 2048; j.n0 = (r >> 5) * 64; j.k0 = (r & 31) * 64; return; }
    i -= TJ_W1;
    { const int b = i >> 1, r = i & 1; j.src = p.in[10] + (size_t)(l * 2 + b) * 128 * 64; j.srcld = 64; j.dst = (bf16_t*)(wl + W_W2) + (size_t)b * 64 * 128; j.K = 128; j.n0 = 0; j.k0 = r * 64; }
}

DEV void rmsnorm_rows_bf16(const float* x, const float* g, bf16_t* H, int gw, int nW, int lane) {
    for (int r0 = gw * 4; r0 < T; r0 += nW * 4) {
        f32x4 v[4][4]; float ss[4];
#pragma unroll
        for (int i = 0; i < 4; ++i) { const f32x4* xr = (const f32x4*)(x + (size_t)(r0 + i) * 1024);
#pragma unroll
            for (int j = 0; j < 4; ++j) v[i][j] = __builtin_nontemporal_load(xr + lane + 64 * j); }
#pragma unroll
        for (int i = 0; i < 4; ++i) { float s = 0.f;
#pragma unroll
            for (int j = 0; j < 4; ++j) s += v[i][j][0] * v[i][j][0] + v[i][j][1] * v[i][j][1] + v[i][j][2] * v[i][j][2] + v[i][j][3] * v[i][j][3];
            ss[i] = s; }
#pragma unroll
        for (int o = 32; o; o >>= 1) {
#pragma unroll
            for (int i = 0; i < 4; ++i) ss[i] += __shfl_xor(ss[i], o); }
#pragma unroll
        for (int i = 0; i < 4; ++i) { const float rs = rsqrtf(ss[i] * (1.0f / 1024.0f) + 1e-6f);
#pragma unroll
            for (int j = 0; j < 4; ++j) { const f32x4 gg = ((const f32x4*)g)[lane + 64 * j];
                u32x2 o; o.x = pk2(v[i][j][0] * rs * gg[0], v[i][j][1] * rs * gg[1]); o.y = pk2(v[i][j][2] * rs * gg[2], v[i][j][3] * rs * gg[3]);
                *(u32x2*)(H + (size_t)(r0 + i) * 1024 + (lane + 64 * j) * 4) = o; } }
    }
}
DEV void rmsnorm_rows_f32(float* x, const float* g, int gw, int nW, int lane) {
    for (int r0 = gw * 4; r0 < T; r0 += nW * 4) {
        f32x4 v[4][4]; float ss[4];
#pragma unroll
        for (int i = 0; i < 4; ++i) { const f32x4* xr = (const f32x4*)(x + (size_t)(r0 + i) * 1024);
#pragma unroll
            for (int j = 0; j < 4; ++j) v[i][j] = __builtin_nontemporal_load(xr + lane + 64 * j); }
#pragma unroll
        for (int i = 0; i < 4; ++i) { float s = 0.f;
#pragma unroll
            for (int j = 0; j < 4; ++j) s += v[i][j][0] * v[i][j][0] + v[i][j][1] * v[i][j][1] + v[i][j][2] * v[i][j][2] + v[i][j][3] * v[i][j][3];
            ss[i] = s; }
#pragma unroll
        for (int o = 32; o; o >>= 1) {
#pragma unroll
            for (int i = 0; i < 4; ++i) ss[i] += __shfl_xor(ss[i], o); }
#pragma unroll
        for (int i = 0; i < 4; ++i) { const float rs = rsqrtf(ss[i] * (1.0f / 1024.0f) + 1e-6f); f32x4* xr = (f32x4*)(x + (size_t)(r0 + i) * 1024);
#pragma unroll
            for (int j = 0; j < 4; ++j) { const f32x4 gg = ((const f32x4*)g)[lane + 64 * j]; __builtin_nontemporal_store(v[i][j] * rs * gg, xr + lane + 64 * j); } }
    }
}

DEV void rope_cs(int pos, int i, float& cs, float& sn) {
    const float inv = exp2f(-(float)i * (13.287712379549449f / 16.0f));
    const float ang = (float)pos * inv;
    double a = (double)ang * 0.15915494309189535; a -= rint(a);
    const float fr = (float)a;
    sn = __builtin_amdgcn_sinf(fr); cs = __builtin_amdgcn_cosf(fr);
}

DEV void mla_q_item(const bf16_t* C, const float* gq, const bf16_t* Wuq, bf16_t* Qb, int item, int lane) {
    const int n = lane & 31, hf = lane >> 5;
    const size_t tok = (size_t)item * 32 + n; const int pos = (int)(tok & (S - 1));
    const bf16_t* row = C + tok * CP + B_CQ + hf * 8;
    bf16x8 xf[12]; float ss = 0.f;
#pragma unroll
    for (int ks = 0; ks < 12; ++ks) { xf[ks] = *(const bf16x8*)(row + ks * 16);
#pragma unroll
        for (int e = 0; e < 8; ++e) { const float v = bf2f((bf16_t)xf[ks][e]); ss += v * v; } }
    ss += __shfl_xor(ss, 32);
    const float rs = rsqrtf(ss * (1.0f / 192.0f) + 1e-6f);
#pragma unroll
    for (int ks = 0; ks < 12; ++ks) { const f32x4 g0 = *(const f32x4*)(gq + ks * 16 + hf * 8), g1 = *(const f32x4*)(gq + ks * 16 + hf * 8 + 4);
        float v[8];
#pragma unroll
        for (int e = 0; e < 8; ++e) v[e] = bf2f((bf16_t)xf[ks][e]) * rs * (e < 4 ? g0[e] : g1[e - 4]);
        xf[ks] = pack8(v[0], v[1], v[2], v[3], v[4], v[5], v[6], v[7]); }
    float cs[8], sn[8];
#pragma unroll
    for (int j = 0; j < 8; ++j) rope_cs(pos, kap(j, hf), cs[j], sn[j]);
    const float QS = 0.10206207261596575f * LOG2E;
#pragma unroll 1
    for (int c = 0; c < 12; ++c) {
        const int head = c / 3, part = c % 3;
        f32x16 acc = zero16();
        const bf16_t* wr_ = Wuq + (size_t)(c * 32 + n) * 192 + hf * 8;
#pragma unroll
        for (int ks = 0; ks < 12; ++ks) acc = MFMA32(*(const bf16x8*)(wr_ + ks * 16), xf[ks], acc);
        if (part == 2) {
#pragma unroll
            for (int j = 0; j < 8; ++j) { const float x1 = acc[j], x2 = acc[j + 8]; acc[j] = x1 * cs[j] - x2 * sn[j]; acc[j + 8] = x1 * sn[j] + x2 * cs[j]; }
        }
        bf16_t* qp = Qb + tok * 384 + head * 96 + part * 32 + hf * 4;
#pragma unroll
        for (int g = 0; g < 4; ++g) { u32x2 o; o.x = pk2(acc[4 * g] * QS, acc[4 * g + 1] * QS); o.y = pk2(acc[4 * g + 2] * QS, acc[4 * g + 3] * QS); *(u32x2*)(qp + g * 8) = o; }
    }
}

DEV void mla_kv_item(const bf16_t* C, const float* gkv, const bf16_t* Wukv, bf16_t* Kb, bf16_t* VTb, int item, int lane) {
    const int n = lane & 31, hf = lane >> 5;
    const size_t tok = (size_t)item * 32 + n; const int pos = (int)(tok & (S - 1)); const int b = (int)(tok >> 13); const int tau = item & 255;
    const bf16_t* row = C + tok * CP + B_CKV + hf * 8;
    bf16x8 xf[8]; float ss = 0.f;
#pragma unroll
    for (int ks = 0; ks < 8; ++ks) { xf[ks] = *(const bf16x8*)(row + ks * 16);
#pragma unroll
        for (int e = 0; e < 8; ++e) { const float v = bf2f((bf16_t)xf[ks][e]); ss += v * v; } }
    ss += __shfl_xor(ss, 32);
    const float rs = rsqrtf(ss * (1.0f / 128.0f) + 1e-6f);
#pragma unroll
    for (int ks = 0; ks < 8; ++ks) { const f32x4 g0 = *(const f32x4*)(gkv + ks * 16 + hf * 8), g1 = *(const f32x4*)(gkv + ks * 16 + hf * 8 + 4);
        float v[8];
#pragma unroll
        for (int e = 0; e < 8; ++e) v[e] = bf2f((bf16_t)xf[ks][e]) * rs * (e < 4 ? g0[e] : g1[e - 4]);
        xf[ks] = pack8(v[0], v[1], v[2], v[3], v[4], v[5], v[6], v[7]); }
    {
        const bf16x8 k1 = *(const bf16x8*)(C + tok * CP + B_KPE + hf * 8), k2 = *(const bf16x8*)(C + tok * CP + B_KPE + 16 + hf * 8);
        float o1[8], o2[8];
#pragma unroll
        for (int e = 0; e < 8; ++e) { float cs, sn; rope_cs(pos, 8 * hf + e, cs, sn); const float x1 = bf2f((bf16_t)k1[e]), x2 = bf2f((bf16_t)k2[e]); o1[e] = x1 * cs - x2 * sn; o2[e] = x1 * sn + x2 * cs; }
        const bf16x8 p1 = pack8(o1[0], o1[1], o1[2], o1[3], o1[4], o1[5], o1[6], o1[7]), p2 = pack8(o2[0], o2[1], o2[2], o2[3], o2[4], o2[5], o2[6], o2[7]);
#pragma unroll
        for (int h = 0; h < 4; ++h) { bf16_t* kt_ = Kb + ((size_t)(b * 4 + h) * 256 + tau) * 3072 + lane * 8; *(bf16x8*)(kt_ + 4 * 512) = p1; *(bf16x8*)(kt_ + 5 * 512) = p2; }
    }
#pragma unroll 1
    for (int c = 0; c < 16; ++c) {
        const int head = c >> 2, part = c & 3;
        f32x16 acc = zero16();
        const bf16_t* wr_ = Wukv + (size_t)(c * 32 + n) * 128 + hf * 8;
#pragma unroll
        for (int ks = 0; ks < 8; ++ks) acc = MFMA32(*(const bf16x8*)(wr_ + ks * 16), xf[ks], acc);
        if (part < 2) {
            bf16_t* kp = Kb + ((size_t)(b * 4 + head) * 256 + tau) * 3072 + n * 8 + 4 * hf;
#pragma unroll
            for (int g = 0; g < 4; ++g) { u32x2 o; o.x = pk2(acc[4 * g], acc[4 * g + 1]); o.y = pk2(acc[4 * g + 2], acc[4 * g + 3]); *(u32x2*)(kp + (part * 2 + (g >> 1)) * 512 + (g & 1) * 256) = o; }
        } else {
            bf16_t* vp = VTb + (((size_t)(b * 4 + head) * 256 + tau) * 4 + (part - 2) * 2 + (n >> 4)) * 512 + ((n >> 2) & 1) * 256 + ((n >> 3) & 1) * 4 + (n & 3);
#pragma unroll
            for (int j = 0; j < 16; ++j) vp[kap(j, hf) * 8] = (bf16_t)(pk2(acc[j], 0.f) & 0xffffu);
        }
    }
}

DEV void vtrans_item(const bf16_t* src  , int tbase, int tstride, bf16_t* dst, size_t rowlen, int lane) {
    const bf16_t* row = src + (size_t)(tbase + lane * tstride) * CP;
    bf16_t* d = dst + lane;
#pragma unroll 2
    for (int i = 0; i < 8; ++i) {
        const bf16x8 v = *(const bf16x8*)(row + i * 8);
#pragma unroll
        for (int e = 0; e < 8; ++e) d[(size_t)e * rowlen] = (bf16_t)v[e];
        d += 8 * rowlen;
    }
}
DEV void vfrag_item(const bf16_t* src  , int tbase, int tstride, bf16_t* dst, int lane) {
    const int n = lane & 31, hf = lane >> 5;
#pragma unroll
    for (int qq = 0; qq < 2; ++qq) {
        bf16_t v[2][8];
#pragma unroll
        for (int e = 0; e < 8; ++e) { const int kp_ = qq * 16 + (e >> 2) * 8 + hf * 4 + (e & 3);
            const bf16_t* row = src + (size_t)(tbase + kp_ * tstride) * CP + n;
            v[0][e] = row[0]; v[1][e] = row[32]; }
#pragma unroll
        for (int d = 0; d < 2; ++d) { u32x4 w; w.x = v[d][0] | ((unsigned)v[d][1] << 16); w.y = v[d][2] | ((unsigned)v[d][3] << 16); w.z = v[d][4] | ((unsigned)v[d][5] << 16); w.w = v[d][6] | ((unsigned)v[d][7] << 16);
            *(u32x4*)(dst + (d * 2 + qq) * 512 + lane * 8) = w; }
    }
}
DEV void kfrag_item(const bf16_t* src, int tbase, bf16_t* dst, int lane) {
    const int n = lane & 31, hf = lane >> 5;
    const bf16_t* row = src + (size_t)(tbase + n) * CP + hf * 8;
#pragma unroll
    for (int ks = 0; ks < 4; ++ks) *(bf16x8*)(dst + ks * 512 + lane * 8) = *(const bf16x8*)(row + ks * 16);
}

DEV void compress_item(const Params& p, unsigned char* ws, int l, int item, LAS float* part, const int tid) {
    const bf16_t* C = (const bf16_t*)(ws + WS_C);
    const int w = tid >> 6, lane = tid & 63, n = lane & 31, hf = lane >> 5;
    const int b = item >> 5, kv = (item >> 4) & 1, ntile = item & 15;
    const int nrow = ntile * 32 + n;
    const bf16_t* W1 = (const bf16_t*)(ws + (size_t)l * W_LAYER + W_W1) + (size_t)kv * 128 * 2048;
    const bf16_t* W2 = (const bf16_t*)(ws + (size_t)l * W_LAYER + W_W2) + (size_t)kv * 64 * 128;
    const float* pe = p.in[7] + (size_t)(l * 2 + kv) * 32 * 64;
    const float* b1 = p.in[9] + (size_t)(l * 2 + kv) * 128;
    const float* b2 = p.in[11] + (size_t)(l * 2 + kv) * 64;
    const int ccol = kv ? C_VC : C_KC;
    f32x16 acc[4];
#pragma unroll
    for (int hc = 0; hc < 4; ++hc) acc[hc] = zero16();
#pragma unroll 1
    for (int li = 0; li < 4; ++li) {
        const int lpos = w * 4 + li;
        int tk = nrow * 16 + lpos; tk = tk < S ? tk : S - 1;
        const bf16_t* trow = C + ((size_t)b * S + tk) * CP + ccol + hf * 8;
        const float* prow = pe + lpos * 64 + hf * 8;
#pragma unroll 1
        for (int ks = 0; ks < 4; ++ks) {
            const bf16x8 tv = *(const bf16x8*)(trow + ks * 16);
            const f32x4 p0 = *(const f32x4*)(prow + ks * 16), p1 = *(const f32x4*)(prow + ks * 16 + 4);
            const bf16x8 xb = pack8(bf2f((bf16_t)tv[0]) + p0[0], bf2f((bf16_t)tv[1]) + p0[1], bf2f((bf16_t)tv[2]) + p0[2], bf2f((bf16_t)tv[3]) + p0[3],
                                    bf2f((bf16_t)tv[4]) + p1[0], bf2f((bf16_t)tv[5]) + p1[1], bf2f((bf16_t)tv[6]) + p1[2], bf2f((bf16_t)tv[7]) + p1[3]);
#pragma unroll
            for (int hc = 0; hc < 4; ++hc) acc[hc] = MFMA32(*(const bf16x8*)(W1 + (size_t)(hc * 32 + n) * 2048 + lpos * 64 + ks * 16 + hf * 8), xb, acc[hc]);
        }
    }
#pragma unroll
    for (int hc = 0; hc < 4; ++hc)
#pragma unroll
        for (int j = 0; j < 16; ++j) part[(w * 128 + hc * 32 + kap(j, hf)) * 32 + n] = acc[hc][j];
    __syncthreads();
#pragma unroll 1
    for (int i = 0; i < 8; ++i) { const int e = tid + 512 * i; float s = 0.f;
#pragma unroll
        for (int ww = 0; ww < 8; ++ww) s += part[ww * 4096 + e];
        s += b1[e >> 5];
        const float u = 0.7978845608028654f * (s + 0.044715f * s * s * s);
        const float th = 1.f - 2.f * rcp(1.f + ex2(2.f * LOG2E * u));
        part[e] = 0.5f * s * (1.f + th); }
    __syncthreads();
    if (w < 2) {
        f32x16 a2 = zero16();
#pragma unroll
        for (int ks = 0; ks < 8; ++ks) {
            float h[8];
#pragma unroll
            for (int e = 0; e < 8; ++e) h[e] = part[(ks * 16 + hf * 8 + e) * 32 + n];
            a2 = MFMA32(*(const bf16x8*)(W2 + (size_t)(w * 32 + n) * 128 + ks * 16 + hf * 8), pack8(h[0], h[1], h[2], h[3], h[4], h[5], h[6], h[7]), a2);
        }
        if (kv == 0) {
            bf16_t* kp = (bf16_t*)(ws + R_KCMP) + ((size_t)b * 16 + ntile) * 2048 + n * 8 + 4 * hf;
#pragma unroll
            for (int g = 0; g < 4; ++g) { const f32x4 bb = *(const f32x4*)(b2 + w * 32 + g * 8 + hf * 4);
                u32x2 o; o.x = pk2(a2[4 * g] + bb[0], a2[4 * g + 1] + bb[1]); o.y = pk2(a2[4 * g + 2] + bb[2], a2[4 * g + 3] + bb[3]); *(u32x2*)(kp + (w * 2 + (g >> 1)) * 512 + (g & 1) * 256) = o; }
        } else {
            bf16_t* vp = (bf16_t*)(ws + R_VTCMP) + (((size_t)b * 16 + ntile) * 4 + w * 2 + (n >> 4)) * 512 + ((n >> 2) & 1) * 256 + ((n >> 3) & 1) * 4 + (n & 3);
#pragma unroll
            for (int j = 0; j < 16; ++j) { const int r = kap(j, hf); vp[r * 8] = (bf16_t)(pk2(a2[j] + b2[w * 32 + r], 0.f) & 0xffffu); }
        }
    }
    __syncthreads();
}

template <int NK> DEV f32x16 qk_tile(const bf16x8 (&qf)[NK], const bf16_t* krow) {
    f32x16 s = zero16();
#pragma unroll
    for (int ks = 0; ks < NK; ++ks) s = MFMA32(*(const bf16x8*)(krow + ks * 16), qf[ks], s);
    return s;
}
DEV void pv_tile(f32x16 (&O)[2], const f32x16& p, const bf16_t* vt, size_t dv32) {
    const bf16x8 pf0 = pack8(p[0], p[1], p[2], p[3], p[4], p[5], p[6], p[7]), pf1 = pack8(p[8], p[9], p[10], p[11], p[12], p[13], p[14], p[15]);
#pragma unroll
    for (int d = 0; d < 2; ++d) { const bf16_t* r = vt + d * dv32;
        const s16x4 a0 = *(const s16x4*)(r), a1 = *(const s16x4*)(r + 8), a2 = *(const s16x4*)(r + 16), a3 = *(const s16x4*)(r + 24);
        const bf16x8 v0 = __builtin_shufflevector(a0, a1, 0, 1, 2, 3, 4, 5, 6, 7), v1 = __builtin_shufflevector(a2, a3, 0, 1, 2, 3, 4, 5, 6, 7);
        O[d] = MFMA32(v0, pf0, O[d]); O[d] = MFMA32(v1, pf1, O[d]); }
}
template <int NK> struct KVF { bf16x8 k[NK]; bf16x8 v[2][2]; };
template <int NK, int KS, bool LV> DEV void load_kv(KVF<NK>& f, const bf16_t* kp, const bf16_t* vp) {
#pragma unroll
    for (int ks = 0; ks < NK; ++ks) f.k[ks] = *(const bf16x8*)(kp + ks * KS);
    if (LV) {
#pragma unroll
        for (int d = 0; d < 2; ++d)
#pragma unroll
            for (int qq = 0; qq < 2; ++qq) f.v[d][qq] = *(const bf16x8*)(vp + (d * 2 + qq) * 512);
    }
}
template <int NK> DEV f32x16 qk_frag(const bf16x8 (&qf)[NK], const KVF<NK>& f) {
    f32x16 s = zero16();
#pragma unroll
    for (int ks = 0; ks < NK; ++ks) s = MFMA32(f.k[ks], qf[ks], s);
    return s;
}
template <int NK> DEV void pv_frag(f32x16 (&O)[2], const f32x16& p, const KVF<NK>& f) {
    const bf16x8 pf0 = pack8(p[0], p[1], p[2], p[3], p[4], p[5], p[6], p[7]), pf1 = pack8(p[8], p[9], p[10], p[11], p[12], p[13], p[14], p[15]);
#pragma unroll
    for (int d = 0; d < 2; ++d) { O[d] = MFMA32(f.v[d][0], pf0, O[d]); O[d] = MFMA32(f.v[d][1], pf1, O[d]); }
}
template <int NK, int KS, bool LV, class Addr, class Step>
DEV void tile_loop(int t0, int t1, Addr addr, Step step) {
    if (t0 >= t1) return;
    const int tl = t1 - 1;
    KVF<NK> A, B;
    { const bf16_t* kp; const bf16_t* vp; addr(t0, kp, vp); load_kv<NK, KS, LV>(A, kp, vp); }
    { const bf16_t* kp; const bf16_t* vp; addr(t0 + 1 < tl ? t0 + 1 : tl, kp, vp); load_kv<NK, KS, LV>(B, kp, vp); }
    int t = t0;
#pragma unroll 1
    for (; t + 1 < t1; t += 2) {
        step(A, t);
        { const bf16_t* kp; const bf16_t* vp; addr(t + 2 < tl ? t + 2 : tl, kp, vp); load_kv<NK, KS, LV>(A, kp, vp); }
        step(B, t + 1);
        { const bf16_t* kp; const bf16_t* vp; addr(t + 3 < tl ? t + 3 : tl, kp, vp); load_kv<NK, KS, LV>(B, kp, vp); }
    }
    if (t < t1) step(A, t);
}
constexpr float RESCALE_THR = 11.5f;
template <bool LAZY = true> DEV void softmax_update(f32x16& s, float& m, float& l, f32x16 (&O)[2]) {
    float mx = s[0];
#pragma unroll
    for (int j = 1; j < 16; ++j) mx = fmaxf(mx, s[j]);
    mx = xhalf_max(mx);
    const float mn = fmaxf(m, mx);
    if (!LAZY || __builtin_amdgcn_ballot_w64(mx > m + RESCALE_THR) != 0ull) {
        const float al = ex2(m - mn); m = mn; l *= al; O[0] *= al; O[1] *= al;
    }
    float rs = 0.f;
#pragma unroll
    for (int j = 0; j < 16; ++j) { const float pj = ex2(s[j] - m); s[j] = pj; rs += pj; }
    rs = xhalf_sum(rs);
    l += rs;
}
DEV void write_gated(const f32x16 (&O)[2], float sc, bf16_t* gp) {
#pragma unroll
    for (int d = 0; d < 2; ++d)
#pragma unroll
        for (int g = 0; g < 4; ++g) { bf16_t* q = gp + d * 32 + g * 8; const u32x2 gv = *(const u32x2*)q;
            const float g0 = bflo(gv.x), g1 = bfhi(gv.x), g2 = bflo(gv.y), g3 = bfhi(gv.y);
            u32x2 o; o.x = pk2(O[d][4 * g] * sc * g0 * sigm(g0), O[d][4 * g + 1] * sc * g1 * sigm(g1)); o.y = pk2(O[d][4 * g + 2] * sc * g2 * sigm(g2), O[d][4 * g + 3] * sc * g3 * sigm(g3));
            *(u32x2*)q = o; }
}

template <int MODE = 0> DEV void mla_item(unsigned char* ws, int b, int h, int qt, int lane) {
    const int n = lane & 31, hf = lane >> 5;
    const bf16_t* Qb = (const bf16_t*)(ws + R_QB); const bf16_t* Kb = (const bf16_t*)(ws + R_KB); const bf16_t* VT = (const bf16_t*)(ws + R_VTB); bf16_t* C = (bf16_t*)(ws + WS_C);
    const size_t tok = (size_t)b * S + qt * 32 + n;
    bf16x8 qf[6];
#pragma unroll
    for (int ks = 0; ks < 6; ++ks) qf[ks] = *(const bf16x8*)(Qb + tok * 384 + h * 96 + hf * 8 + ks * 16);
    f32x16 O[2]; O[0] = zero16(); O[1] = zero16(); float m = NEG, l = 0.f;
    const bf16_t* kp0 = Kb + (size_t)(b * 4 + h) * 256 * 3072 + lane * 8;
    const bf16_t* vp0 = VT + (size_t)(b * 4 + h) * 256 * 2048 + lane * 8;
    tile_loop<6, 512, true>(0, qt + 1,
        [&](int t, const bf16_t*& kp, const bf16_t*& vp) { kp = kp0 + (size_t)t * 3072; vp = vp0 + (size_t)t * 2048; },
        [&](const KVF<6>& f, int t) {
            if (MODE == 3) { bf16x8 x = f.k[0];
#pragma unroll
                for (int ks = 1; ks < 6; ++ks) x ^= f.k[ks];
                x ^= f.v[0][0] ^ f.v[0][1] ^ f.v[1][0] ^ f.v[1][1]; O[0][0] += (float)x[0]; return; }
            f32x16 s = qk_frag<6>(qf, f);
            if (MODE == 2) { O[0] += s; return; }
            if (t == qt) {
#pragma unroll
                for (int j = 0; j < 16; ++j) if (kap(j, hf) > n) s[j] = NEG;
            }
            softmax_update<false>(s, m, l, O);
            pv_frag<6>(O, s, f);
        });
    if (MODE == 0) write_gated(O, rcp(l), C + tok * CP + B_G + h * 64 + hf * 4);
    else if (O[0][0] + O[1][3] + l == 1.2345e-20f) C[tok * CP + CP - 1] = 0;
}

template <int MODE = 0> DEV void sb_item(unsigned char* ws, int b, int h, int qt, int lane) {
    const int n = lane & 31, hf = lane >> 5;
    bf16_t* C = (bf16_t*)(ws + WS_C); const bf16_t* VT = (const bf16_t*)(ws + R_VTD);
    const size_t tok = (size_t)b * S + qt * 32 + n;
    bf16x8 qf[4];
#pragma unroll
    for (int ks = 0; ks < 4; ++ks) qf[ks] = *(const bf16x8*)(C + tok * CP + D_Q + h * 64 + hf * 8 + ks * 16);
    const float c = 0.125f * LOG2E;
    f32x16 O[2]; O[0] = zero16(); O[1] = zero16(); float carry = 0.f;
    const bf16_t* kp = C + ((size_t)b * S + n) * CP + D_K + h * 64 + hf * 8;
    const bf16_t* vp = VT + ((size_t)(b * 4 + h) * 64 + n) * S + hf * 4;
#pragma unroll 1
    for (int kt = qt; kt >= 0; --kt) {
        f32x16 s = qk_tile<4>(qf, kp + (size_t)kt * 32 * CP);
        f32x16 L;
#pragma unroll
        for (int j = 0; j < 16; ++j) { const float z = s[j] * c; const bool valid = (kt < qt) || (kap(j, hf) < n);
            const float sp = fmaxf(z, 0.f) + lg2(1.f + ex2(-fabsf(z)));
            L[j] = valid ? -sp : 0.f; s[j] = valid ? z : NEG; }
        float sg[4], pg[4];
#pragma unroll
        for (int g = 0; g < 4; ++g) { L[4 * g + 2] += L[4 * g + 3]; L[4 * g + 1] += L[4 * g + 2]; L[4 * g] += L[4 * g + 1]; sg[g] = L[4 * g]; }
#pragma unroll
        for (int g = 0; g < 4; ++g) pg[g] = xhalf_get(sg[g], hf);
        float run = carry;
#pragma unroll
        for (int g = 3; g >= 0; --g) { const float base = run + (hf == 0 ? pg[g] : 0.f);
#pragma unroll
            for (int i = 0; i < 4; ++i) s[4 * g + i] = ex2(s[4 * g + i] + base + L[4 * g + i]);
            run += sg[g] + pg[g]; }
        carry = run;
        pv_tile(O, s, vp + kt * 32, (size_t)32 * S);
        if (__builtin_amdgcn_ballot_w64(carry > -64.f) == 0ull) break;
    }
    if (MODE == 0) write_gated(O, 1.f, C + tok * CP + D_G + h * 64 + hf * 4);
    else if (O[0][0] + O[1][3] == 1.2345e-20f) C[tok * CP + CP - 1] = 0;
}

template <int MODE = 0> DEV void dsw_item(unsigned char* ws, int b, int h, int r, int ut, int lane) {
    const int n = lane & 31, hf = lane >> 5;
    bf16_t* C = (bf16_t*)(ws + WS_C);
    const int tq = r + 16 * (ut * 32 + n);
    const size_t tok = (size_t)b * S + tq;
    bf16x8 qf[4];
#pragma unroll
    for (int ks = 0; ks < 4; ++ks) qf[ks] = *(const bf16x8*)(C + tok * CP + A_Q + h * 64 + hf * 8 + ks * 16);
    const float c = 0.125f * LOG2E, sl2 = LOG2E * 0.5f / (float)(1 << (2 * h));
    f32x16 O[2]; O[0] = zero16(); O[1] = zero16(); float m = NEG, l = 0.f;
    const bf16_t* kb = C + (size_t)b * S * CP + A_K + h * 64 + hf * 8;
    const size_t vrow = (size_t)(b * 4 + h) * 256 * 2048 + lane * 8;
    {
        const bf16_t* vb = (const bf16_t*)(ws + R_VTA16) + vrow + (size_t)r * 16 * 2048;
        const int ub = ut * 32 - 128;
        tile_loop<4, 16, true>(ut < 4 ? 4 - ut : 0, 5,
            [&](int t, const bf16_t*& kp, const bf16_t*& vp) { const int us = ub + t * 32; kp = kb + (size_t)(r + 16 * (us + n)) * CP; vp = vb + (size_t)(us >> 5) * 2048; },
            [&](const KVF<4>& f, int t) { const int us = ub + t * 32; f32x16 s = qk_frag<4>(qf, f);
#pragma unroll
                for (int j = 0; j < 16; ++j) { const int dist = tq - (r + 16 * (us + kap(j, hf))); s[j] = (dist >= 0 && dist <= 2048) ? s[j] * c - sl2 * (float)dist : NEG; }
                softmax_update(s, m, l, O); pv_frag<4>(O, s, f); });
    }
    {
        const int r4 = r & 3;
        const bf16_t* vb = (const bf16_t*)(ws + R_VTA4) + vrow + (size_t)r4 * 64 * 2048;
        const int ub = ut * 128 - 128;
        tile_loop<4, 16, true>(ut == 0 ? 4 : 0, 8,
            [&](int t, const bf16_t*& kp, const bf16_t*& vp) { const int us = ub + t * 32; kp = kb + (size_t)(r4 + 4 * (us + n)) * CP; vp = vb + (size_t)(us >> 5) * 2048; },
            [&](const KVF<4>& f, int t) { const int us = ub + t * 32; f32x16 s = qk_frag<4>(qf, f);
#pragma unroll
                for (int j = 0; j < 16; ++j) { const int dist = tq - (r4 + 4 * (us + kap(j, hf))); s[j] = (dist >= 0 && dist <= 512) ? s[j] * c - sl2 * (float)dist : NEG; }
                softmax_update(s, m, l, O); pv_frag<4>(O, s, f); });
    }
    {
        const bf16_t* vb = (const bf16_t*)(ws + R_VTA1) + vrow;
        const int tb = ut * 512 - 128;
        const bf16_t* kf1 = (const bf16_t*)(ws + R_KFA1) + vrow;
        tile_loop<4, 512, true>(ut == 0 ? 4 : 0, 20,
            [&](int t, const bf16_t*& kp, const bf16_t*& vp) { const int ts = tb + t * 32; kp = kf1 + (size_t)(ts >> 5) * 2048; vp = vb + (size_t)(ts >> 5) * 2048; },
            [&](const KVF<4>& f, int t) { const int ts = tb + t * 32; f32x16 s = qk_frag<4>(qf, f);
#pragma unroll
                for (int j = 0; j < 16; ++j) { const int dist = tq - (ts + kap(j, hf)); s[j] = (dist >= 0 && dist <= 128) ? s[j] * c - sl2 * (float)dist : NEG; }
                softmax_update(s, m, l, O); pv_frag<4>(O, s, f); });
    }
    if (MODE == 0) write_gated(O, rcp(l), C + tok * CP + A_G + h * 64 + hf * 4);
    else if (O[0][0] + O[1][3] + l == 1.2345e-20f) C[tok * CP + CP - 1] = 0;
}

template <int MODE = 0> DEV void nsa_item(unsigned char* ws, int b, int q0, int lane, LAS float* Asel  , LAS float* Bsel  , LAS float* stash  ) {
    const int n = lane & 31, hf = lane >> 5, ql = n >> 2, hd = n & 3;
    bf16_t* C = (bf16_t*)(ws + WS_C);
    const int t = q0 + ql, tmax = q0 + 7;
    const size_t tok = (size_t)b * S + t;
    const float c = 0.125f * LOG2E, sl2 = LOG2E * 0.25f / (float)(1 << (2 * hd));
    bf16x8 qf[4];
#pragma unroll
    for (int ks = 0; ks < 4; ++ks) qf[ks] = *(const bf16x8*)(C + tok * CP + C_Q + hd * 64 + hf * 8 + ks * 16);
    float g0, g1, g2;
    { const bf16_t* gp = C + tok * CP + C_GT + hd * 3; g0 = sigm(bf2f(gp[0])); g1 = sigm(bf2f(gp[1])); g2 = sigm(bf2f(gp[2])); }
#pragma unroll
    for (int i = 0; i < 32; ++i) Asel[lane + 64 * i] = 0.f;
    {
        const int ntiles = (tmax >= 31) ? ((((tmax - 31) >> 4) >> 5) + 1) : 0;
        const bf16_t* kc = (const bf16_t*)(ws + R_KCMP) + (size_t)b * 16 * 2048 + lane * 8;
        const bf16_t* vc = (const bf16_t*)(ws + R_VTCMP) + (size_t)b * 16 * 2048 + lane * 8;
        float m = NEG, l = 0.f;
        auto addr = [&](int nt, const bf16_t*& kp, const bf16_t*& vp) { kp = kc + (size_t)nt * 2048; vp = vc + (size_t)nt * 2048; };
        tile_loop<4, 512, false>(0, ntiles, addr,
            [&](const KVF<4>& f, int nt) { f32x16 s = qk_frag<4>(qf, f);
                float mx = NEG;
#pragma unroll
                for (int j = 0; j < 16; ++j) { const int dist = t - (16 * (nt * 32 + kap(j, hf)) + 31); s[j] = dist >= 0 ? s[j] * c - sl2 * (float)dist : NEG; mx = fmaxf(mx, s[j]); }
                mx = xhalf_max(mx);
                const float mn = fmaxf(m, mx); float rs = 0.f;
#pragma unroll
                for (int j = 0; j < 16; ++j) rs += (s[j] > -1e29f) ? ex2(s[j] - mn) : 0.f;
                rs = xhalf_sum(rs);
                l = l * ex2(m - mn) + rs; m = mn; });
        const float il = l > 0.f ? 1.0f / l : 0.f;
        f32x16 Oc[2]; Oc[0] = zero16(); Oc[1] = zero16();
        tile_loop<4, 512, true>(0, ntiles, addr,
            [&](const KVF<4>& f, int nt) { f32x16 s = qk_frag<4>(qf, f);
#pragma unroll
                for (int j = 0; j < 16; ++j) { const int dist = t - (16 * (nt * 32 + kap(j, hf)) + 31); s[j] = dist >= 0 ? ex2(s[j] * c - sl2 * (float)dist - m) * il : 0.f; }
#pragma unroll
                for (int g = 0; g < 4; ++g) { float a = s[4 * g], bb = a + 2.f * (s[4 * g + 1] + s[4 * g + 2] + s[4 * g + 3]);
                    a += dpp_quad<0xB1>(a); a += dpp_quad<0x4E>(a); bb += dpp_quad<0xB1>(bb); bb += dpp_quad<0x4E>(bb);
                    if (hd == 0) { const int js = nt * 8 + 2 * g + hf; Asel[ql * 128 + js] = a; Bsel[ql * 128 + js] = bb; } }
                pv_frag<4>(Oc, s, f); });
#pragma unroll
        for (int d = 0; d < 2; ++d)
#pragma unroll
            for (int j = 0; j < 16; ++j) stash[(d * 16 + j) * 64 + lane] = Oc[d][j] * g0;
    }
    unsigned long long mylo = 0ull, myhi = 0ull, ulo = 0ull, uhi = 0ull;
#pragma unroll 1
    for (int q = 0; q < 8; ++q) {
        const int tq = q0 + q, cur = tq >> 6;
        LAS float* Aq = Asel + q * 128; LAS float* Bq = Bsel + q * 128;
        unsigned k0, k1; bool va0, va1;
        { const int j = lane; va0 = j * 64 <= tq; const bool forced = (j == 0) || (j == cur) || (j == cur - 1);
          const float ps = Aq[j] + (j > 0 ? Bq[j > 0 ? j - 1 : 0] : 0.f); const float sc = forced ? 1e9f : ps;
          k0 = va0 ? (((__builtin_bit_cast(unsigned, sc) >> 6) << 7) | (unsigned)(127 - j)) : 0u; }
        { const int j = lane + 64; va1 = j * 64 <= tq; const bool forced = (j == cur) || (j == cur - 1);
          const float ps = Aq[j] + Bq[j - 1]; const float sc = forced ? 1e9f : ps;
          k1 = va1 ? (((__builtin_bit_cast(unsigned, sc) >> 6) << 7) | (unsigned)(127 - j)) : 0u; }
        LAS unsigned* Kq = (LAS unsigned*)Aq;
        Kq[lane] = k0; Kq[lane + 64] = k1;
        int r0 = 0, r1 = 0;
#pragma unroll 8
        for (int jj = 0; jj < 128; jj += 4) { const u32x4 v = *(const LAS u32x4*)(Kq + jj);
#pragma unroll
            for (int e = 0; e < 4; ++e) { r0 += (v[e] > k0) ? 1 : 0; r1 += (v[e] > k1) ? 1 : 0; } }
        const unsigned long long lo = __builtin_amdgcn_ballot_w64(va0 && r0 < 16), hi = __builtin_amdgcn_ballot_w64(va1 && r1 < 16);
        ulo |= lo; uhi |= hi; if (ql == q) { mylo = lo; myhi = hi; }
    }
    if (MODE == 2) { if ((ulo ^ uhi ^ mylo) == 0x123456789abcdefull) C[tok * CP + CP - 1] = 0; return; }
    if (MODE != 3) {
        LAS int* list = (LAS int*)Asel;
        int ntl = 0;
#pragma unroll 1
        for (int w = 0; w < 2; ++w) {
            unsigned long long um = w ? uhi : ulo;
            while (um) { const int bit = __builtin_ctzll(um); um &= um - 1ull; const int ts = (bit + 64 * w) * 64;
                if (ts <= tmax) { list[ntl++] = ts; if (ts + 32 <= tmax) list[ntl++] = ts + 32; } }
        }
        f32x16 O[2]; O[0] = zero16(); O[1] = zero16(); float m = NEG, l = 0.f;
        const bf16_t* kb = (const bf16_t*)(ws + R_KFCS) + (size_t)b * 256 * 2048 + lane * 8;
        const bf16_t* vb = (const bf16_t*)(ws + R_VTCS) + (size_t)b * 256 * 2048 + lane * 8;
        tile_loop<4, 512, true>(0, ntl,
            [&](int i, const bf16_t*& kp, const bf16_t*& vp) { const int ts = __builtin_amdgcn_readfirstlane(list[i]); kp = kb + (size_t)(ts >> 5) * 2048; vp = vb + (size_t)(ts >> 5) * 2048; },
            [&](const KVF<4>& f, int i) { const int ts = __builtin_amdgcn_readfirstlane(list[i]); const int jb = ts >> 6;
                const bool mysel = ((jb < 64 ? (mylo >> jb) : (myhi >> (jb - 64))) & 1ull) != 0ull;
                f32x16 s = qk_frag<4>(qf, f);
                if (ts + 31 <= q0) {
                    const float bt = mysel ? -sl2 * (float)(t - ts - 4 * hf) : NEG;
#pragma unroll
                    for (int j = 0; j < 16; ++j) s[j] = fmaf(s[j], c, fmaf((float)(8 * (j >> 2) + (j & 3)), sl2, bt));
                } else {
#pragma unroll
                    for (int j = 0; j < 16; ++j) { const int dist = t - (ts + kap(j, hf)); s[j] = (mysel && dist >= 0) ? s[j] * c - sl2 * (float)dist : NEG; }
                }
                softmax_update(s, m, l, O); pv_frag<4>(O, s, f); });
        const float sc = g1 * rcp(l);
#pragma unroll
        for (int d = 0; d < 2; ++d)
#pragma unroll
            for (int j = 0; j < 16; ++j) stash[(d * 16 + j) * 64 + lane] += O[d][j] * sc;
    }
    {
        f32x16 O[2]; O[0] = zero16(); O[1] = zero16(); float m = NEG, l = 0.f;
        const bf16_t* kb = (const bf16_t*)(ws + R_KFCW) + (size_t)b * 256 * 2048 + lane * 8;
        const bf16_t* vb = (const bf16_t*)(ws + R_VTCW) + (size_t)b * 256 * 2048 + lane * 8;
        const int ws0 = (q0 > 511 ? q0 - 511 : 0) & ~31;
        tile_loop<4, 512, true>(0, ((tmax - ws0) >> 5) + 1,
            [&](int i, const bf16_t*& kp, const bf16_t*& vp) { const int ts = ws0 + i * 32; kp = kb + (size_t)(ts >> 5) * 2048; vp = vb + (size_t)(ts >> 5) * 2048; },
            [&](const KVF<4>& f, int i) { const int ts = ws0 + i * 32; f32x16 s = qk_frag<4>(qf, f);
                if (ts + 31 <= q0 && ts >= q0 - 504) {
                    const float bt = -sl2 * (float)(t - ts - 4 * hf);
#pragma unroll
                    for (int j = 0; j < 16; ++j) s[j] = fmaf(s[j], c, fmaf((float)(8 * (j >> 2) + (j & 3)), sl2, bt));
                } else {
#pragma unroll
                    for (int j = 0; j < 16; ++j) { const int dist = t - (ts + kap(j, hf)); s[j] = (dist >= 0 && dist < 512) ? s[j] * c - sl2 * (float)dist : NEG; }
                }
                softmax_update(s, m, l, O); pv_frag<4>(O, s, f); });
        const float sc = g2 * rcp(l);
#pragma unroll
        for (int d = 0; d < 2; ++d)
#pragma unroll
            for (int j = 0; j < 16; ++j) O[d][j] = O[d][j] * sc + stash[(d * 16 + j) * 64 + lane];
        if (MODE == 0) write_gated(O, 1.f, C + tok * CP + C_G + hd * 64 + hf * 4);
        else if (O[0][0] + O[1][3] == 1.2345e-20f) C[tok * CP + CP - 1] = 0;
    }
}


#define XB_TMO      128
#define XB_XCNT(j)  (256  + 64 * (j))
#define XB_XSUB(j)  (1280 + 64 * (j))
#define XB_XGEN(j)  (2304 + 64 * (j))
#define XB_TOP      3328
#define XB_TOPGEN   3392
#define XCD_BAR_WORDS 3456
#define XB_SPIN_CAP (1u << 18)
DEV unsigned xb_ld(unsigned* p)              { return __hip_atomic_load(p, __ATOMIC_RELAXED, __HIP_MEMORY_SCOPE_AGENT); }
DEV unsigned xb_add(unsigned* p, unsigned v) { return __hip_atomic_fetch_add(p, v, __ATOMIC_RELAXED, __HIP_MEMORY_SCOPE_AGENT); }
DEV unsigned xb_xcc_id() { return (unsigned)__builtin_amdgcn_s_getreg((3 << 11) | 20) & 0xFu; }
#define XB_SPIN(cond, bar) do { unsigned _sp = 0; while (cond) { __builtin_amdgcn_s_sleep(1); \
    if ((++_sp & 255u) == 0u) { if (xb_ld(&(bar)[XB_TMO])) break; if (_sp > XB_SPIN_CAP) { atomicAdd(&(bar)[XB_TMO], 1u); break; } } } } while (0)
struct XcdBarrier { unsigned* bar; unsigned x; volatile LAS unsigned* st; };
DEV XcdBarrier xcd_barrier_post(unsigned* bar, volatile LAS unsigned* st) {
    XcdBarrier b; b.bar = bar; b.x = xb_xcc_id(); b.st = st;
    if (threadIdx.x == 0) (void)xb_add(&bar[XB_XCNT(b.x)], 1u);
    return b;
}
DEV void xcd_barrier_complete(unsigned* bar, unsigned x, unsigned& nloc, unsigned& nx) {
    const unsigned G = gridDim.x * gridDim.y * gridDim.z;
    unsigned sum, cnt, mine, sp = 0u;
    for (;;) {
        sum = 0u; cnt = 0u; mine = 0u;
#pragma unroll
        for (unsigned j = 0; j < 16; ++j) { const unsigned c = xb_ld(&bar[XB_XCNT(j)]); sum += c; cnt += (c > 0u) ? 1u : 0u; mine = (j == x) ? c : mine; }
        if (sum == G) break;
        __builtin_amdgcn_s_sleep(1);
        if ((++sp & 255u) == 0u) { if (xb_ld(&bar[XB_TMO])) break; if (sp > XB_SPIN_CAP) { atomicAdd(&bar[XB_TMO], 1u); break; } }
    }
    nloc = mine > 0u ? mine : 1u; nx = cnt > 0u ? cnt : 1u;
}
DEV void xcd_barrier(const XcdBarrier& b) {
    asm volatile("s_waitcnt vmcnt(0)" ::: "memory");
    __syncthreads();
    if (threadIdx.x == 0) {
        unsigned* bar = b.bar;
        __builtin_amdgcn_s_waitcnt(0);
        unsigned nloc = b.st[0], nx = b.st[1];
        if (nloc == 0u) { xcd_barrier_complete(bar, b.x, nloc, nx); b.st[0] = nloc; b.st[1] = nx; }
        const unsigned old = xb_add(&bar[XB_XSUB(b.x)], 1u);
        const unsigned gen = old / nloc;
        if (old + 1u == (gen + 1u) * nloc) {
            __builtin_amdgcn_fence(__ATOMIC_RELEASE, "agent");
            asm volatile("s_waitcnt vmcnt(0)" ::: "memory");
            const unsigned og = xb_add(&bar[XB_TOP], 1u);
            const unsigned tg = og / nx;
            if (og + 1u == (tg + 1u) * nx) xb_add(&bar[XB_TOPGEN], 1u);
            else XB_SPIN(xb_ld(&bar[XB_TOPGEN]) == tg, bar);
            __builtin_amdgcn_fence(__ATOMIC_ACQUIRE, "agent");
            xb_add(&bar[XB_XGEN(b.x)], 1u);
            asm volatile("s_waitcnt vmcnt(0)" ::: "memory");
        } else {
            XB_SPIN(xb_ld(&bar[XB_XGEN(b.x)]) == gen, bar);
            __builtin_amdgcn_fence(__ATOMIC_ACQUIRE, "agent");
            asm volatile("s_waitcnt vmcnt(0)" ::: "memory");
        }
    }
    __syncthreads();
}

#define FRESH() int tid = threadIdx.x; asm volatile("" : "+v"(tid)); size_t zoff_ = 0; asm volatile("" : "+s"(zoff_)); unsigned char* ws = p.ws + zoff_; \
    const int lane = tid & 63, wv = __builtin_amdgcn_readfirstlane(tid >> 6), gw = cb * 8 + wv; (void)lane; (void)gw; (void)ws;
__global__ void __launch_bounds__(512, 2) mega(Params p) {
    extern __shared__ __attribute__((aligned(16))) unsigned char smem[];
    cg::grid_group grid = cg::this_grid();
    LAS unsigned char* lds = (LAS unsigned char*)smem;
    const int G = gridDim.x, cb = blockIdx.x, nW = G * 8;
    volatile LAS unsigned* xst = (volatile LAS unsigned*)(lds + LDS_RING);
    if (threadIdx.x == 0) { xst[0] = 0u; xst[1] = 0u; }
    __syncthreads();
    const XcdBarrier xb = xcd_barrier_post((unsigned*)(p.ws + WS_BAR), xst);
    for (int ph = p.ph_lo; ph < p.ph_hi; ++ph) {
        if (ph > p.ph_lo) xcd_barrier(xb);
        if (p.ph_hi < 0) grid.sync();
        const int l = (ph >= 7) ? 1 : 0;
        const int lp = (ph == 0) ? 0 : (ph <= 5 ? ph : (ph == 6 ? 0 : (ph <= 11 ? ph - 6 : 12)));
        const size_t wlo = (size_t)l * W_LAYER;
#ifdef DBL_MASK
        const int reps = (((DBL_MASK) >> lp) & 1) ? 2 : 1;
#else
        const int reps = 1;
#endif
        for (int rep = 0; rep < reps; ++rep) {
        if (ph == 0) {
            { FRESH(); for (int i = cb; i < 2 * TJ_LAYER; i += G) { TJob j; make_tjob(p, ws, i, j); transpose_tile(j, (LAS float*)lds, tid); } }
            { FRESH(); rmsnorm_rows_bf16(p.in[0], p.in[1], (bf16_t*)(ws + WS_H), gw, nW, lane); }
        } else if (ph == 6) {
            FRESH(); rmsnorm_rows_bf16(p.out, p.in[1] + 1024, (bf16_t*)(ws + WS_H), gw, nW, lane);
        } else if (lp == 12) {
            FRESH(); rmsnorm_rows_f32(p.out, p.in[16], gw, nW, lane);
        } else if (lp == 1) {
            FRESH();
            pg8::SchedIn Sd{(const char*)(ws + WS_H), (const char*)(ws + wlo + W_IN), G, cb};
            pg8::EpiIn E{(bf16_t*)(ws + WS_C)};
            pg8::gemm_phase(lds, Sd, E, tid);
        } else if (lp == 2) {
#ifndef SK_CMP
            { FRESH(); for (int i = G - 1 - cb; i < 128; i += G) compress_item(p, ws, l, i, (LAS float*)lds, tid); }
#endif
#ifndef SK_Q
            { FRESH(); for (int i = gw; i < 1024; i += nW) mla_q_item((const bf16_t*)(ws + WS_C), p.in[3] + l * 192, (const bf16_t*)(ws + wlo + W_UQ), (bf16_t*)(ws + R_QB), i, lane); }
#endif
#ifndef SK_KV
            { FRESH(); for (int i = nW - 1 - gw; i < 1024; i += nW) mla_kv_item((const bf16_t*)(ws + WS_C), p.in[5] + l * 128, (const bf16_t*)(ws + wlo + W_UKV), (bf16_t*)(ws + R_KB), (bf16_t*)(ws + R_VTB), i, lane); }
#endif
#ifndef SK_VT
            { FRESH(); const bf16_t* C = (const bf16_t*)(ws + WS_C);
            for (int i = gw; i < 3 * 16 * 256 + 16 * 128 + 4 * 4 * 256 + 16 * 256; i += nW) {
                if (i < 3 * 16 * 256) {
                    const int kind = i >> 12, bh = (i >> 8) & 15, tl = i & 255; const int b = bh >> 2, h = bh & 3;
                    const bf16_t* src = C + (size_t)b * S * CP + A_V + h * 64;
                    bf16_t* dst = (bf16_t*)(ws + (kind == 0 ? R_VTA1 : kind == 1 ? R_VTA4 : R_VTA16)) + ((size_t)bh * 256 + tl) * 2048;
                    if (kind == 0) vfrag_item(src, tl * 32, 1, dst, lane);
                    else if (kind == 1) { const int r4 = tl >> 6, u0 = (tl & 63) * 32; vfrag_item(src, r4 + 4 * u0, 4, dst, lane); }
                    else { const int r16 = tl >> 4, u0 = (tl & 15) * 32; vfrag_item(src, r16 + 16 * u0, 16, dst, lane); }
                } else if (i < 3 * 16 * 256 + 16 * 128) {
                    const int k = i - 3 * 16 * 256; const int bh = k >> 7, tl = k & 127; const int b = bh >> 2, h = bh & 3;
                    vtrans_item(C + (size_t)b * S * CP + D_V + h * 64, tl * 64, 1, (bf16_t*)(ws + R_VTD) + (size_t)bh * 64 * S + tl * 64, S, lane);
                } else if (i >= 3 * 16 * 256 + 16 * 128 + 4 * 4 * 256) {
                    const int k = i - (3 * 16 * 256 + 16 * 128 + 4 * 4 * 256); const int bh = k >> 8, tl = k & 255;
                    kfrag_item(C + (size_t)(bh >> 2) * S * CP + A_K + (bh & 3) * 64, tl * 32, (bf16_t*)(ws + R_KFA1) + ((size_t)bh * 256 + tl) * 2048, lane);
                } else {
                    const int k = i - (3 * 16 * 256 + 16 * 128); const int kind = k >> 10, b = (k >> 8) & 3, tl = k & 255;
                    const bf16_t* src = C + (size_t)b * S * CP + (kind == 0 ? C_VS : kind == 1 ? C_VW : kind == 2 ? C_KS : C_KW);
                    bf16_t* dst = (bf16_t*)(ws + (kind == 0 ? R_VTCS : kind == 1 ? R_VTCW : kind == 2 ? R_KFCS : R_KFCW)) + ((size_t)b * 256 + tl) * 2048;
                    if (kind < 2) vfrag_item(src, tl * 32, 1, dst, lane); else kfrag_item(src, tl * 32, dst, lane);
                }
            } }
#endif
        } else if (lp == 3) {
#ifndef SK_MLA
            { FRESH(); for (int k = 0; k * G < 512; ++k) { const int g = k * G + ((k & 1) ? G - 1 - cb : cb); if (g >= 512) continue;
                const int bh = (G == 256) ? (cb & 7) + 8 * k : (g & 15), qt8 = (G == 256) ? (k ? (cb >> 3) : 31 - (cb >> 3)) : 31 - (g >> 4);
#ifdef EXP_MLA
                mla_item<EXP_MLA>(ws, bh >> 2, bh & 3, qt8 * 8 + wv, lane);
#endif
                mla_item(ws, bh >> 2, bh & 3, qt8 * 8 + wv, lane); } }
#endif
#ifndef SK_NSA
            { FRESH(); for (int k = 0; k * G < 512; ++k) { const int g = k * G + ((k & 1) ? G - 1 - cb : cb); if (g >= 512) continue;
                const int qg = 127 - (g >> 2), b = g & 3; LAS float* As = (LAS float*)lds + wv * 4096;
#ifdef EXP_NSA
                nsa_item<EXP_NSA>(ws, b, qg * 64 + wv * 8, lane, As, As + 1024, As + 2048);
#endif
                nsa_item(ws, b, qg * 64 + wv * 8, lane, As, As + 1024, As + 2048); } }
#endif
#ifndef SK_DSW
            { FRESH(); for (int k = 0; k * G < 512; ++k) { const int g = k * G + ((k & 1) ? G - 1 - cb : cb); if (g >= 512) continue;
                const int bh = (G == 256) ? (cb & 7) + 8 * k : (g & 15), ut = (G == 256) ? ((cb >> 3) & 15) : ((g >> 4) & 15), oc = (G == 256) ? (cb >> 7) : (g >> 8);
#ifdef EXP_DSW
                dsw_item<1>(ws, bh >> 2, bh & 3, oc * 8 + wv, ut, lane);
#endif
                dsw_item(ws, bh >> 2, bh & 3, oc * 8 + wv, ut, lane); } }
#endif
#ifndef SK_SB
            { FRESH(); for (int k = 0; k * G < 512; ++k) { const int g = k * G + ((k & 1) ? G - 1 - cb : cb); if (g >= 512) continue;
                const int bh = (G == 256) ? (cb & 7) + 8 * k : (g & 15), qt8 = (G == 256) ? (k ? (cb >> 3) : 31 - (cb >> 3)) : 31 - (g >> 4);
#ifdef EXP_SB
                sb_item<1>(ws, bh >> 2, bh & 3, qt8 * 8 + wv, lane);
#endif
                sb_item(ws, bh >> 2, bh & 3, qt8 * 8 + wv, lane); } }
#endif
        } else if (lp == 4) {
            FRESH();
            pg8::SchedMerge Sd{(const char*)(ws + WS_H), (const char*)(ws + WS_C), (const char*)(ws + wlo + W_MG), (const char*)(ws + wlo + W_BR), G, cb};
            pg8::EpiMerge E{p.in[14] + (size_t)l * 4096, (bf16_t*)(ws + R_GS) + (size_t)cb * 65536, (bf16_t*)(ws + R_MACC) + (size_t)cb * 65536, (bf16_t*)(ws + R_MB)};
            pg8::gemm_phase(lds, Sd, E, tid);
        } else if (lp == 5) {
            FRESH();
            pg8::SchedOut Sd{(const char*)(ws + R_MB), (const char*)(ws + wlo + W_OUT), G, cb};
            pg8::EpiOut E{l == 0 ? p.in[0] : (const float*)p.out, p.out};
            pg8::gemm_phase(lds, Sd, E, tid);
        }
        __syncthreads();
        }
    }
#ifdef DBG_K
    {
        asm volatile("s_waitcnt vmcnt(0) lgkmcnt(0)" ::: "memory");
        __syncthreads();
        if (threadIdx.x < 64) { __builtin_amdgcn_fence(__ATOMIC_RELEASE, "agent"); asm volatile("s_waitcnt vmcnt(0)" ::: "memory"); }
        grid.sync();
        __builtin_amdgcn_fence(__ATOMIC_ACQUIRE, "agent"); asm volatile("s_waitcnt vmcnt(0)" ::: "memory");
        const bf16_t* src = (const bf16_t*)(p.ws + DBG_OFF);
        const size_t nel = (size_t)(DBG_BYTES) / 2, NO = (size_t)T * 1024;
        for (size_t i = (size_t)blockIdx.x * 512 + threadIdx.x; i < NO; i += (size_t)gridDim.x * 512) {
            float s = 0.f;
            for (size_t k = i; k < nel; k += NO) s += bf2f(src[k]);
            p.out[i] = s;
        }
    }
#endif
}

extern "C" void kernel_launch(void* const* d_in, const int* in_sizes, int n_in, void* d_out, int out_size, void* d_ws, size_t ws_size, hipStream_t stream) {
    static int grid_blocks = 0;
    if (!grid_blocks) {
        if (hipFuncSetAttribute((const void*)mega, hipFuncAttributeMaxDynamicSharedMemorySize, LDS_BYTES) != hipSuccess) { fprintf(stderr, "hipFuncSetAttribute failed\n"); return; }
        int dev = 0, cus = 0, per_cu = 0;
        hipGetDevice(&dev);
        hipDeviceGetAttribute(&cus, hipDeviceAttributeMultiprocessorCount, dev);
        hipOccupancyMaxActiveBlocksPerMultiprocessor(&per_cu, mega, 512, LDS_BYTES);
        if (per_cu < 1) { fprintf(stderr, "occupancy query returned %d\n", per_cu); return; }
        grid_blocks = cus;
        if (grid_blocks > 256) grid_blocks = 256;
    }
    if (ws_size < WS_TOTAL) { fprintf(stderr, "workspace too small: %zu < %zu\n", ws_size, (size_t)WS_TOTAL); return; }
    (void)hipMemsetAsync((unsigned char*)d_ws + WS_BAR, 0, 16384, stream);
    Params p{};
    for (int i = 0; i < 17; ++i) p.in[i] = (const float*)d_in[i];
#ifdef DBG_K
    p.out = (float*)d_out; p.ws = (unsigned char*)d_ws; p.ph_lo = 0; p.ph_hi = DBG_K;
#else
    p.out = (float*)d_out; p.ws = (unsigned char*)d_ws; p.ph_lo = 0; p.ph_hi = 13;
#endif
    void* args[] = {&p};
    hipError_t e = hipLaunchCooperativeKernel((const void*)mega, dim3(grid_blocks), dim3(512), args, LDS_BYTES, stream);
    if (e != hipSuccess) fprintf(stderr, "cooperative launch failed: %s (grid %d)\n", hipGetErrorString(e), grid_blocks);
}
```

```cpp
#include <hip/hip_runtime.h>
#include <hip/hip_cooperative_groups.h>
#include <cstdio>
#include <cstdint>
namespace cg = cooperative_groups;

#define LAS __attribute__((address_space(3)))
#define DEV __device__ __forceinline__
typedef unsigned short bf16_t;
typedef short bf16x8 __attribute__((ext_vector_type(8)));
typedef short s16x4 __attribute__((ext_vector_type(4)));
typedef float f32x2 __attribute__((ext_vector_type(2)));
typedef float f32x4 __attribute__((ext_vector_type(4)));
typedef float f32x16 __attribute__((ext_vector_type(16)));
typedef unsigned u32x2 __attribute__((ext_vector_type(2)));
typedef unsigned u32x4 __attribute__((ext_vector_type(4)));

constexpr int NB = 4, S = 8192, T = NB * S, DM = 1024, CP = 3584;
constexpr int A_Q = 0, A_K = 256, A_V = 512, A_G = 768, B_G = 1024, C_Q = 1280, C_G = 1536, D_Q = 1792, D_K = 2048, D_V = 2304, D_G = 2560,
              B_CQ = 2816, B_CKV = 3008, B_KPE = 3136, C_KC = 3168, C_VC = 3232, C_KS = 3296, C_VS = 3360, C_KW = 3424, C_VW = 3488, C_GT = 3552;
constexpr float LOG2E = 1.44269504088896f;
constexpr float NEG = -1e30f;

constexpr size_t W_IN = 0, W_MG = W_IN + (size_t)CP * 1024 * 2, W_BR = W_MG + (size_t)4096 * 1024 * 2, W_OUT = W_BR + (size_t)4096 * 256 * 2,
                 W_UQ = W_OUT + (size_t)1024 * 1024 * 2, W_UKV = W_UQ + (size_t)384 * 192 * 2, W_W1 = W_UKV + (size_t)512 * 128 * 2,
                 W_W2 = W_W1 + (size_t)2 * 128 * 2048 * 2, W_LAYER = W_W2 + (size_t)2 * 64 * 128 * 2;
constexpr size_t WS_H = 2 * W_LAYER, WS_C = WS_H + (size_t)T * 1024 * 2, WS_R = WS_C + (size_t)T * CP * 2;
constexpr size_t R_QB = WS_R, R_KB = R_QB + (size_t)T * 384 * 2, R_VTB = R_KB + (size_t)T * 384 * 2, R_VTD = R_VTB + (size_t)T * 256 * 2,
                 R_VTA1 = R_VTD + (size_t)T * 256 * 2, R_VTA4 = R_VTA1 + (size_t)T * 256 * 2, R_VTA16 = R_VTA4 + (size_t)T * 256 * 2,
                 R_VTCS = R_VTA16 + (size_t)T * 256 * 2, R_VTCW = R_VTCS + (size_t)T * 64 * 2, R_KCMP = R_VTCW + (size_t)T * 64 * 2,
                 R_VTCMP = R_KCMP + (size_t)NB * 512 * 64 * 2, R_KFCS = R_VTCMP + (size_t)NB * 512 * 64 * 2, R_KFCW = R_KFCS + (size_t)T * 64 * 2, R_KFA1 = R_KFCW + (size_t)T * 64 * 2, R_END1 = R_KFA1 + (size_t)T * 256 * 2;
constexpr size_t R_MB = WS_R, R_GS = R_MB + (size_t)T * 1024 * 2, R_MACC = R_GS + (size_t)256 * 65536 * 2, R_END2 = R_MACC + (size_t)256 * 65536 * 2;
constexpr size_t WS_NEED = (R_END1 > R_END2 ? R_END1 : R_END2);
constexpr size_t WS_BAR = (WS_NEED + 255) & ~(size_t)255, WS_TOTAL = WS_BAR + 16384;
constexpr int LDS_RING = 131072, LDS_BYTES = LDS_RING + 64;

struct Params { const float* in[17]; float* out; unsigned char* ws; int ph_lo, ph_hi; };

DEV float ex2(float x) { return __builtin_amdgcn_exp2f(x); }
DEV float lg2(float x) { return __builtin_amdgcn_logf(x); }
DEV float rcp(float x) { return __builtin_amdgcn_rcpf(x); }
DEV float sigm(float x) { return rcp(1.f + ex2(-LOG2E * x)); }
typedef __bf16 bf16x2_t __attribute__((ext_vector_type(2)));
DEV unsigned pk2(float lo, float hi) { const f32x2 v = {lo, hi}; const bf16x2_t b = __builtin_convertvector(v, bf16x2_t); return __builtin_bit_cast(unsigned, b); }
DEV float bflo(unsigned u) { return __builtin_bit_cast(float, u << 16); }
DEV float bfhi(unsigned u) { return __builtin_bit_cast(float, u & 0xffff0000u); }
DEV float bf2f(bf16_t v) { return __builtin_bit_cast(float, (unsigned)v << 16); }
DEV void xhalf_pair(float x, float& a, float& b) {
    a = x;
    asm volatile("v_mov_b32 %1, %0\n\ts_nop 1\n\tv_permlane32_swap_b32 %0, %1\n\ts_nop 1" : "+v"(a), "=&v"(b));
}
template <int CTRL> DEV float dpp_quad(float x) { return __builtin_bit_cast(float, __builtin_amdgcn_update_dpp(0, __builtin_bit_cast(int, x), CTRL, 0xF, 0xF, false)); }
DEV float xhalf_get(float x, int hf) { float a, b; xhalf_pair(x, a, b); return hf ? a : b; }
DEV float xhalf_max(float x) { float a, b; xhalf_pair(x, a, b); return fmaxf(a, b); }
DEV float xhalf_sum(float x) { float a, b; xhalf_pair(x, a, b); return a + b; }
DEV float wave_sum(float v) {
#pragma unroll
    for (int o = 32; o; o >>= 1) v += __shfl_xor(v, o);
    return v;
}
DEV bf16x8 pack8(float a0, float a1, float a2, float a3, float a4, float a5, float a6, float a7) {
    u32x4 w; w.x = pk2(a0, a1); w.y = pk2(a2, a3); w.z = pk2(a4, a5); w.w = pk2(a6, a7); return __builtin_bit_cast(bf16x8, w);
}
#define MFMA32(a, b, c) __builtin_amdgcn_mfma_f32_32x32x16_bf16((a), (b), (c), 0, 0, 0)
DEV f32x16 zero16() { f32x16 z;
#pragma unroll
    for (int j = 0; j < 16; ++j) z[j] = 0.f; return z; }
DEV int kap(int j, int hf) { return 8 * (j >> 2) + 4 * hf + (j & 3); }

DEV int orig_col(int n) {
    if (n < 1024) return n;
    if (n < 1280) return n - 1024 + 1376;
    if (n < 1536) return n - 1280 + 1632;
    if (n < 1792) return n - 1536 + 2284;
    if (n < 2048) return n - 1792 + 2540;
    if (n < 2304) return n - 2048 + 2796;
    if (n < 2560) return n - 2304 + 3052;
    if (n < 2816) return n - 2560 + 3308;
    if (n < 3008) return n - 2816 + 1024;
    if (n < 3136) return n - 3008 + 1216;
    if (n < 3168) return n - 3136 + 1344;
    if (n < 3552) return n - 3168 + 1888;
    if (n < 3564) return n - 3552 + 2272;
    return -1;
}

namespace pg8 {
constexpr int BM = 256, BK = 64, HALF = 128, HTB = HALF * BK * 2;
DEV int lds_byte(int r, int c) { const int st = (r >> 4) * 2 + (c >> 5), rr = r & 15, cc = c & 31, ob = rr * 64 + cc * 2; return st * 1024 + (ob ^ (((ob >> 9) & 1) << 5)); }
DEV void stage_rc(int b, int& R, int& C) { const int st = b / 1024, sb = b % 1024, swz = sb ^ (((sb >> 9) & 1) << 5); R = (st >> 1) * 16 + swz / 64; C = (st & 1) * 32 + (swz % 64) / 2; }
DEV int perm32(int rho) { const int n = rho >> 4, i = rho & 15; return 8 * (i >> 2) + 4 * n + (i & 3); }

struct GUnit { const char* A; const char* B; int lda2, ldb2, nt, kind, pm, pn; };

template <class Epi, class Sched>
DEV void gemm_phase(LAS unsigned char* lds, const Sched& S, const Epi& E, const int tid) {
    const int wid = __builtin_amdgcn_readfirstlane(tid >> 6), lane = tid & 63, wr = wid >> 2, wc = wid & 3, fr = lane & 15, fq = lane >> 4;
    int R0, C0; stage_rc(tid * 16, R0, C0);
    const int Rb0 = (R0 & ~31) + perm32(R0 & 31);
    const unsigned c2 = (unsigned)C0 * 2u;
    const unsigned ldsw = (unsigned)wid * 1024u;
    const int aoff = lds_byte(wr * 64 + fr, fq * 8), boff = lds_byte(wc * 32 + fr, fq * 8);
    const size_t kstep = (size_t)(BK * 2);
#define PG8_SA(b, h) (((b) * 2 + (h)) * HTB)
#define PG8_SB(b, h) ((4 + (b) * 2 + (h)) * HTB)
#define PG8_STAGE(bufoff, gbase, RR, ld2) do { _Pragma("unroll") for (int _i = 0; _i < 2; ++_i) \
        __builtin_amdgcn_global_load_lds((const unsigned*)((const char*)(gbase) + (size_t)((unsigned)((RR) + 64 * _i) * (unsigned)(ld2) + c2)), (LAS unsigned*)(lds + (bufoff) + ldsw + _i * 8192), 16, 0, 0); } while (0)
#define PG8_LDA(dst, b, h) do { _Pragma("unroll") for (int m = 0; m < 4; ++m) _Pragma("unroll") for (int k = 0; k < 2; ++k) dst[m][k] = *(const LAS bf16x8*)(lds + PG8_SA(b, h) + aoff + m * 2048 + k * 1024); } while (0)
#define PG8_LDB(dst, b, h) do { _Pragma("unroll") for (int n = 0; n < 2; ++n) _Pragma("unroll") for (int k = 0; k < 2; ++k) dst[n][k] = *(const LAS bf16x8*)(lds + PG8_SB(b, h) + boff + n * 2048 + k * 1024); } while (0)
#define PG8_MMA(ai, bj, At, Bt) do { __builtin_amdgcn_s_setprio(1); _Pragma("unroll") for (int m = 0; m < 4; ++m) _Pragma("unroll") for (int n = 0; n < 2; ++n) _Pragma("unroll") for (int k = 0; k < 2; ++k) \
        acc[ai][bj][m][n] = __builtin_amdgcn_mfma_f32_16x16x32_bf16(Bt[n][k], At[m][k], acc[ai][bj][m][n], 0, 0, 0); __builtin_amdgcn_s_setprio(0); } while (0)
#define PG8_WAIT_V(n) asm volatile("s_waitcnt vmcnt(" #n ")" ::: "memory")
#define PG8_WAIT_L(n) asm volatile("s_waitcnt lgkmcnt(" #n ")" ::: "memory")
#define PG8_BAR __builtin_amdgcn_s_barrier()
#define PG8_SCHED __builtin_amdgcn_sched_barrier(0)
    GUnit cur, nxt; int ui = 0;
    if (!S.next(0, cur)) return;
    f32x4 acc[2][2][4][2];
#pragma unroll
    for (int a = 0; a < 2; ++a)
#pragma unroll
        for (int b = 0; b < 2; ++b)
#pragma unroll
            for (int m = 0; m < 4; ++m)
#pragma unroll
                for (int n = 0; n < 2; ++n) acc[a][b][m][n] = (f32x4){0.f, 0.f, 0.f, 0.f};
    bf16x8 At[4][2], B0[2][2], B1[2][2];
    const char* cA = cur.A; const char* cB = cur.B; int clda = cur.lda2, cldb = cur.ldb2;
    {
        const size_t chA = (size_t)HALF * clda, chB = (size_t)HALF * cldb;
        PG8_STAGE(PG8_SB(0, 0), cB, Rb0, cldb); PG8_STAGE(PG8_SB(0, 1), cB + chB, Rb0, cldb); PG8_STAGE(PG8_SA(0, 0), cA, R0, clda); PG8_STAGE(PG8_SA(0, 1), cA + chA, R0, clda);
        if (wr == 1) PG8_BAR;
        PG8_WAIT_V(2); PG8_BAR;
        PG8_STAGE(PG8_SB(1, 0), cB + kstep, Rb0, cldb); PG8_STAGE(PG8_SA(1, 0), cA + kstep, R0, clda); PG8_STAGE(PG8_SB(1, 1), cB + chB + kstep, Rb0, cldb);
        PG8_WAIT_V(6); PG8_BAR;
    }
    for (;;) {
        const bool has_next = S.next(ui + 1, nxt);
        const char* nA = has_next ? nxt.A : cA; const char* nB = has_next ? nxt.B : cB;
        const int nlda = has_next ? nxt.lda2 : clda, nldb = has_next ? nxt.ldb2 : cldb;
        const int nt = cur.nt;
        const size_t chA = (size_t)HALF * clda;
        for (int t = 0; t < nt; t += 2) {
            const bool last = (t == nt - 2);
            const char* a1 = cA + (size_t)(t + 1) * kstep;
            const char* a2 = last ? nA : cA + (size_t)(t + 2) * kstep; const char* b2 = last ? nB : cB + (size_t)(t + 2) * kstep;
            const int l2a = last ? nlda : clda, l2b = last ? nldb : cldb;
            const size_t h2a = (size_t)HALF * l2a, h2b = (size_t)HALF * l2b;
            const char* a3 = a2 + kstep; const char* b3 = b2 + kstep;
            PG8_LDB(B0, 0, 0); PG8_LDB(B1, 0, 1); PG8_SCHED; PG8_LDA(At, 0, 0); PG8_STAGE(PG8_SA(1, 1), a1 + chA, R0, clda);
            PG8_WAIT_V(8); PG8_WAIT_L(0); PG8_BAR; PG8_MMA(0, 0, At, B0); PG8_MMA(0, 1, At, B1); PG8_BAR; PG8_SCHED;
            PG8_LDA(At, 0, 1); PG8_STAGE(PG8_SB(0, 0), b2, Rb0, l2b); PG8_STAGE(PG8_SB(0, 1), b2 + h2b, Rb0, l2b); PG8_STAGE(PG8_SA(0, 0), a2, R0, l2a);
            PG8_WAIT_V(8); PG8_WAIT_L(0); PG8_BAR; PG8_MMA(1, 0, At, B0); PG8_MMA(1, 1, At, B1); PG8_BAR; PG8_SCHED;
            PG8_LDB(B0, 1, 0); PG8_LDB(B1, 1, 1); PG8_SCHED; PG8_LDA(At, 1, 0); PG8_STAGE(PG8_SA(0, 1), a2 + h2a, R0, l2a);
            PG8_WAIT_V(8); PG8_WAIT_L(0); PG8_BAR; PG8_MMA(0, 0, At, B0); PG8_MMA(0, 1, At, B1); PG8_BAR; PG8_SCHED;
            PG8_LDA(At, 1, 1); PG8_STAGE(PG8_SB(1, 0), b3, Rb0, l2b); PG8_STAGE(PG8_SB(1, 1), b3 + h2b, Rb0, l2b); PG8_STAGE(PG8_SA(1, 0), a3, R0, l2a);
            PG8_WAIT_V(8); PG8_WAIT_L(0); PG8_BAR; PG8_MMA(1, 0, At, B0); PG8_MMA(1, 1, At, B1); PG8_BAR; PG8_SCHED;
        }
        if (wr == 0) PG8_BAR;
        E(acc, cur, wr, wc, fr, fq);
        if (!has_next) break;
#pragma unroll
        for (int a = 0; a < 2; ++a)
#pragma unroll
            for (int b = 0; b < 2; ++b)
#pragma unroll
                for (int m = 0; m < 4; ++m)
#pragma unroll
                    for (int n = 0; n < 2; ++n) acc[a][b][m][n] = (f32x4){0.f, 0.f, 0.f, 0.f};
        cur = nxt; cA = nA; cB = nB; clda = nlda; cldb = nldb; ++ui;
        if (wr == 1) PG8_BAR;
    }
    PG8_WAIT_V(0);
    PG8_BAR;
#undef PG8_SA
#undef PG8_SB
#undef PG8_STAGE
#undef PG8_LDA
#undef PG8_LDB
#undef PG8_MMA
#undef PG8_WAIT_V
#undef PG8_WAIT_L
#undef PG8_BAR
#undef PG8_SCHED
}

struct SchedIn {
    const char* H; const char* W; int G, c;
    DEV bool next(int i, GUnit& u) const {
        const int L = i * G + c; if (L >= 128 * 14) return false;
        u.pm = L & 127; u.pn = L >> 7; u.kind = 0; u.nt = 16; u.lda2 = 2048; u.ldb2 = 2048;
        u.A = H + (size_t)u.pm * 256 * 2048; u.B = W + (size_t)u.pn * 256 * 2048; return true;
    }
};
struct SchedMerge {
    const char* H; const char* Cb; const char* WMG; const char* WBR; int G, c;
    DEV bool next(int i, GUnit& u) const {
        const int p = i >> 3, st = i & 7; const int L = p * G + c; if (L >= 512) return false;
        u.pm = (L & 7) | ((L >> 5) << 3); u.pn = (L >> 3) & 3; u.kind = st; const int br = st >> 1;
        if (!(st & 1)) { u.A = H + (size_t)u.pm * 256 * 2048; u.lda2 = 2048; u.B = WMG + (size_t)(br * 1024 + u.pn * 256) * 2048; u.ldb2 = 2048; u.nt = 16; }
        else { const int gc = br == 0 ? A_G : br == 1 ? B_G : br == 2 ? C_G : D_G;
               u.A = Cb + ((size_t)u.pm * 256 * CP + gc) * 2; u.lda2 = CP * 2; u.B = WBR + (size_t)(br * 1024 + u.pn * 256) * 512; u.ldb2 = 512; u.nt = 4; }
        return true;
    }
};
struct SchedOut {
    const char* Mb; const char* W; int G, c;
    DEV bool next(int i, GUnit& u) const {
        const int L = i * G + c; if (L >= 512) return false;
        u.pm = (L & 7) | ((L >> 5) << 3); u.pn = (L >> 3) & 3; u.kind = 0; u.nt = 16; u.lda2 = 2048; u.ldb2 = 2048;
        u.A = Mb + (size_t)u.pm * 256 * 2048; u.B = W + (size_t)u.pn * 256 * 2048; return true;
    }
};

struct EpiIn {
    bf16_t* C;
    DEV void operator()(const f32x4 (&acc)[2][2][4][2], const GUnit& u, int wr, int wc, int fr, int fq) const {
        int row0 = u.pm * BM + wr * 64 + fr, col0 = u.pn * BM + wc * 32 + 8 * fq;
        asm volatile("" : "+v"(row0), "+v"(col0));
        const __amdgpu_buffer_rsrc_t rs = __builtin_amdgcn_make_buffer_rsrc((void*)C, (short)0, (int)((size_t)T * CP * 2), 0x00020000);
#pragma unroll
        for (int ai = 0; ai < 2; ++ai)
#pragma unroll
            for (int m = 0; m < 4; ++m) { const unsigned ro = ((unsigned)(row0 + ai * HALF + m * 16) * (unsigned)CP + (unsigned)col0) * 2u;
#pragma unroll
                for (int bj = 0; bj < 2; ++bj) { const f32x4 v0 = acc[ai][bj][m][0], v1 = acc[ai][bj][m][1];
                    u32x4 w; w.x = pk2(v0[0], v0[1]); w.y = pk2(v0[2], v0[3]); w.z = pk2(v1[0], v1[1]); w.w = pk2(v1[2], v1[3]);
                    __builtin_amdgcn_raw_buffer_store_b128(w, rs, ro + bj * HALF * 2, 0,   16); } }
    }
};
struct EpiMerge {
    const float* bm;
    bf16_t* Gs; bf16_t* Macc; bf16_t* Mb;
    DEV void operator()(const f32x4 (&acc)[2][2][4][2], const GUnit& u, int wr, int wc, int fr, int fq) const {
        const int br = u.kind >> 1;
        int rr0 = wr * 64 + fr, cc0 = wc * 32 + 8 * fq;
        asm volatile("" : "+v"(rr0), "+v"(cc0));
        if (!(u.kind & 1)) {
            f32x4 bv[2][2];
#pragma unroll
            for (int bj = 0; bj < 2; ++bj)
#pragma unroll
                for (int n = 0; n < 2; ++n) bv[bj][n] = *(const f32x4*)(bm + br * 1024 + u.pn * 256 + cc0 + bj * HALF + 4 * n);
#pragma unroll
            for (int ai = 0; ai < 2; ++ai)
#pragma unroll
                for (int m = 0; m < 4; ++m) { const int rr = rr0 + ai * HALF + m * 16;
#pragma unroll
                    for (int bj = 0; bj < 2; ++bj) { const f32x4 v0 = acc[ai][bj][m][0] + bv[bj][0], v1 = acc[ai][bj][m][1] + bv[bj][1];
                        u32x4 w; w.x = pk2(sigm(v0[0]), sigm(v0[1])); w.y = pk2(sigm(v0[2]), sigm(v0[3])); w.z = pk2(sigm(v1[0]), sigm(v1[1])); w.w = pk2(sigm(v1[2]), sigm(v1[3]));
                        *(u32x4*)(Gs + rr * 256 + cc0 + bj * HALF) = w; } }
        } else {
#pragma unroll
            for (int ai = 0; ai < 2; ++ai)
#pragma unroll
                for (int bj = 0; bj < 2; ++bj) {
                    const int idx0 = (rr0 + ai * HALF) * 256 + cc0 + bj * HALF;
                    u32x4 g[4], mc[4];
#pragma unroll
                    for (int m = 0; m < 4; ++m) g[m] = __builtin_nontemporal_load((const u32x4*)(Gs + idx0 + m * 4096));
                    if (br > 0) {
#pragma unroll
                        for (int m = 0; m < 4; ++m) mc[m] = __builtin_nontemporal_load((const u32x4*)(Macc + idx0 + m * 4096));
                    }
#pragma unroll
                    for (int m = 0; m < 4; ++m) { const int idx = idx0 + m * 4096;
                        f32x4 v0 = acc[ai][bj][m][0], v1 = acc[ai][bj][m][1];
                        v0[0] *= bflo(g[m].x); v0[1] *= bfhi(g[m].x); v0[2] *= bflo(g[m].y); v0[3] *= bfhi(g[m].y);
                        v1[0] *= bflo(g[m].z); v1[1] *= bfhi(g[m].z); v1[2] *= bflo(g[m].w); v1[3] *= bfhi(g[m].w);
                        if (br > 0) { v0[0] += bflo(mc[m].x); v0[1] += bfhi(mc[m].x); v0[2] += bflo(mc[m].y); v0[3] += bfhi(mc[m].y);
                                      v1[0] += bflo(mc[m].z); v1[1] += bfhi(mc[m].z); v1[2] += bflo(mc[m].w); v1[3] += bfhi(mc[m].w); }
                        u32x4 w; w.x = pk2(v0[0], v0[1]); w.y = pk2(v0[2], v0[3]); w.z = pk2(v1[0], v1[1]); w.w = pk2(v1[2], v1[3]);
                        if (br < 3) *(u32x4*)(Macc + idx) = w;
                        else { *(u32x4*)(Mb + (size_t)(u.pm * BM + rr0 + ai * HALF + m * 16) * 1024 + u.pn * BM + cc0 + bj * HALF) = w; } }
                }
        }
    }
};
struct EpiOut {
    const float* xin; float* xout;
    DEV void operator()(const f32x4 (&acc)[2][2][4][2], const GUnit& u, int wr, int wc, int fr, int fq) const {
        const int row0 = u.pm * BM + wr * 64 + fr, col0 = u.pn * BM + wc * 32 + 8 * fq;
#pragma unroll
        for (int ai = 0; ai < 2; ++ai)
#pragma unroll
            for (int m = 0; m < 4; ++m) { const size_t ro = (size_t)(row0 + ai * HALF + m * 16) * 1024 + col0;
#pragma unroll
                for (int bj = 0; bj < 2; ++bj) { const size_t o = ro + bj * HALF;
                    const f32x4 x0 = *(const f32x4*)(xin + o), x1 = *(const f32x4*)(xin + o + 4);
                    *(f32x4*)(xout + o) = x0 + acc[ai][bj][m][0]; *(f32x4*)(xout + o + 4) = x1 + acc[ai][bj][m][1]; } }
    }
};
}

struct TJob { const float* src; int srcld; int mode; bf16_t* dst; int K; int n0, k0; };
DEV void transpose_tile(const TJob& j, LAS float* tile, const int tid) {
    { const int nl = tid & 63, kr = tid >> 6; const int n = j.n0 + nl; const int col = j.mode ? orig_col(n) : n;
#pragma unroll
      for (int ps = 0; ps < 8; ++ps) { const int k = ps * 8 + kr; tile[k * 65 + nl] = (col >= 0) ? j.src[(size_t)(j.k0 + k) * j.srcld + col] : 0.f; } }
    __syncthreads();
    { const int kk = (tid & 31) * 2, nr = tid >> 5;
#pragma unroll
      for (int ps = 0; ps < 4; ++ps) { const int nn = ps * 16 + nr; *(unsigned*)(j.dst + (size_t)(j.n0 + nn) * j.K + j.k0 + kk) = pk2(tile[kk * 65 + nn], tile[(kk + 1) * 65 + nn]); } }
    __syncthreads();
}
constexpr int TJ_IN = 56 * 16, TJ_MG = 4 * 256, TJ_BR = 4 * 64, TJ_OUT = 256, TJ_UQ = 18, TJ_UKV = 16, TJ_W1 = 128, TJ_W2 = 4;
constexpr int TJ_LAYER = TJ_IN + TJ_MG + TJ_BR + TJ_OUT + TJ_UQ + TJ_UKV + TJ_W1 + TJ_W2;
DEV void make_tjob(const Params& p, unsigned char* ws, int idx, TJob& j) {
    const int l = idx / TJ_LAYER; int i = idx % TJ_LAYER;
    unsigned char* wl = ws + (size_t)l * W_LAYER;
    j.mode = 0;
    if (i < TJ_IN) { j.src = p.in[2] + (size_t)l * 1024 * 3564; j.srcld = 3564; j.mode = 1; j.dst = (bf16_t*)(wl + W_IN); j.K = 1024; j.n0 = (i / 16) * 64; j.k0 = (i % 16) * 64; return; }
    i -= TJ_IN;
    if (i < TJ_MG) { const int b = i >> 8, r = i & 255; j.src = p.in[13] + (size_t)(l * 4 + b) * 1024 * 1024; j.srcld = 1024; j.dst = (bf16_t*)(wl + W_MG) + (size_t)b * 1024 * 1024; j.K = 1024; j.n0 = (r >> 4) * 64; j.k0 = (r & 15) * 64; return; }
    i -= TJ_MG;
    if (i < TJ_BR) { const int b = i >> 6, r = i & 63; j.src = p.in[12] + (size_t)(l * 4 + b) * 256 * 1024; j.srcld = 1024; j.dst = (bf16_t*)(wl + W_BR) + (size_t)b * 1024 * 256; j.K = 256; j.n0 = (r >> 2) * 64; j.k0 = (r & 3) * 64; return; }
    i -= TJ_BR;
    if (i < TJ_OUT) { j.src = p.in[15] + (size_t)l * 1024 * 1024; j.srcld = 1024; j.dst = (bf16_t*)(wl + W_OUT); j.K = 1024; j.n0 = (i >> 4) * 64; j.k0 = (i & 15) * 64; return; }
    i -= TJ_OUT;
    if (i < TJ_UQ) { j.src = p.in[4] + (size_t)l * 192 * 384; j.srcld = 384; j.dst = (bf16_t*)(wl + W_UQ); j.K = 192; j.n0 = (i / 3) * 64; j.k0 = (i % 3) * 64; return; }
    i -= TJ_UQ;
    if (i < TJ_UKV) { j.src = p.in[6] + (size_t)l * 128 * 512; j.srcld = 512; j.dst = (bf16_t*)(wl + W_UKV); j.K = 128; j.n0 = (i >> 1) * 64; j.k0 = (i & 1) * 64; return; }
    i -= TJ_UKV;
    if (i < TJ_W1) { const int b = i >> 6, r = i & 63; j.src = p.in[8] + (size_t)(l * 2 + b) * 2048 * 128; j.srcld = 128; j.dst = (bf16_t*)(wl + W_W1) + (size_t)b * 128 * 2048; j.K = 2048; j.n0 = (r >> 5) * 64; j.k0 = (r & 31) * 64; return; }
    i -= TJ_W1;
    { const int b = i >> 1, r = i & 1; j.src = p.in[10] + (size_t)(l * 2 + b) * 128 * 64; j.srcld = 64; j.dst = (bf16_t*)(wl + W_W2) + (size_t)b * 64 * 128; j.K = 128; j.n0 = 0; j.k0 = r * 64; }
}

DEV void rmsnorm_rows_bf16(const float* x, const float* g, bf16_t* H, int gw, int nW, int lane) {
    for (int r0 = gw * 4; r0 < T; r0 += nW * 4) {
        f32x4 v[4][4]; float ss[4];
#pragma unroll
        for (int i = 0; i < 4; ++i) { const f32x4* xr = (const f32x4*)(x + (size_t)(r0 + i) * 1024);
#pragma unroll
            for (int j = 0; j < 4; ++j) v[i][j] = __builtin_nontemporal_load(xr + lane + 64 * j); }
#pragma unroll
        for (int i = 0; i < 4; ++i) { float s = 0.f;
#pragma unroll
            for (int j = 0; j < 4; ++j) s += v[i][j][0] * v[i][j][0] + v[i][j][1] * v[i][j][1] + v[i][j][2] * v[i][j][2] + v[i][j][3] * v[i][j][3];
            ss[i] = s; }
#pragma unroll
        for (int o = 32; o; o >>= 1) {
#pragma unroll
            for (int i = 0; i < 4; ++i) ss[i] += __shfl_xor(ss[i], o); }
#pragma unroll
        for (int i = 0; i < 4; ++i) { const float rs = rsqrtf(ss[i] * (1.0f / 1024.0f) + 1e-6f);
#pragma unroll
            for (int j = 0; j < 4; ++j) { const f32x4 gg = ((const f32x4*)g)[lane + 64 * j];
                u32x2 o; o.x = pk2(v[i][j][0] * rs * gg[0], v[i][j][1] * rs * gg[1]); o.y = pk2(v[i][j][2] * rs * gg[2], v[i][j][3] * rs * gg[3]);
                *(u32x2*)(H + (size_t)(r0 + i) * 1024 + (lane + 64 * j) * 4) = o; } }
    }
}
DEV void rmsnorm_rows_f32(float* x, const float* g, int gw, int nW, int lane) {
    for (int r0 = gw * 4; r0 < T; r0 += nW * 4) {
        f32x4 v[4][4]; float ss[4];
#pragma unroll
        for (int i = 0; i < 4; ++i) { const f32x4* xr = (const f32x4*)(x + (size_t)(r0 + i) * 1024);
#pragma unroll
            for (int j = 0; j < 4; ++j) v[i][j] = __builtin_nontemporal_load(xr + lane + 64 * j); }
#pragma unroll
        for (int i = 0; i < 4; ++i) { float s = 0.f;
#pragma unroll
            for (int j = 0; j < 4; ++j) s += v[i][j][0] * v[i][j][0] + v[i][j][1] * v[i][j][1] + v[i][j][2] * v[i][j][2] + v[i][j][3] * v[i][j][3];
            ss[i] = s; }
#pragma unroll
        for (int o = 32; o; o >>= 1) {
#pragma unroll
            for (int i = 0; i < 4; ++i) ss[i] += __shfl_xor(ss[i], o); }
#pragma unroll
        for (int i = 0; i < 4; ++i) { const float rs = rsqrtf(ss[i] * (1.0f / 1024.0f) + 1e-6f); f32x4* xr = (f32x4*)(x + (size_t)(r0 + i) * 1024);
#pragma unroll
            for (int j = 0; j < 4; ++j) { const f32x4 gg = ((const f32x4*)g)[lane + 64 * j]; __builtin_nontemporal_store(v[i][j] * rs * gg, xr + lane + 64 * j); } }
    }
}

DEV void rope_cs(int pos, int i, float& cs, float& sn) {
    const float inv = exp2f(-(float)i * (13.287712379549449f / 16.0f));
    const float ang = (float)pos * inv;
    double a = (double)ang * 0.15915494309189535; a -= rint(a);
    const float fr = (float)a;
    sn = __builtin_amdgcn_sinf(fr); cs = __builtin_amdgcn_cosf(fr);
}

DEV void mla_q_item(const bf16_t* C, const float* gq, const bf16_t* Wuq, bf16_t* Qb, int item, int lane) {
    const int n = lane & 31, hf = lane >> 5;
    const size_t tok = (size_t)item * 32 + n; const int pos = (int)(tok & (S - 1));
    const bf16_t* row = C + tok * CP + B_CQ + hf * 8;
    bf16x8 xf[12]; float ss = 0.f;
#pragma unroll
    for (int ks = 0; ks < 12; ++ks) { xf[ks] = *(const bf16x8*)(row + ks * 16);
#pragma unroll
        for (int e = 0; e < 8; ++e) { const float v = bf2f((bf16_t)xf[ks][e]); ss += v * v; } }
    ss += __shfl_xor(ss, 32);
    const float rs = rsqrtf(ss * (1.0f / 192.0f) + 1e-6f);
#pragma unroll
    for (int ks = 0; ks < 12; ++ks) { const f32x4 g0 = *(const f32x4*)(gq + ks * 16 + hf * 8), g1 = *(const f32x4*)(gq + ks * 16 + hf * 8 + 4);
        float v[8];
#pragma unroll
        for (int e = 0; e < 8; ++e) v[e] = bf2f((bf16_t)xf[ks][e]) * rs * (e < 4 ? g0[e] : g1[e - 4]);
        xf[ks] = pack8(v[0], v[1], v[2], v[3], v[4], v[5], v[6], v[7]); }
    float cs[8], sn[8];
#pragma unroll
    for (int j = 0; j < 8; ++j) rope_cs(pos, kap(j, hf), cs[j], sn[j]);
    const float QS = 0.10206207261596575f * LOG2E;
#pragma unroll 1
    for (int c = 0; c < 12; ++c) {
        const int head = c / 3, part = c % 3;
        f32x16 acc = zero16();
        const bf16_t* wr_ = Wuq + (size_t)(c * 32 + n) * 192 + hf * 8;
#pragma unroll
        for (int ks = 0; ks < 12; ++ks) acc = MFMA32(*(const bf16x8*)(wr_ + ks * 16), xf[ks], acc);
        if (part == 2) {
#pragma unroll
            for (int j = 0; j < 8; ++j) { const float x1 = acc[j], x2 = acc[j + 8]; acc[j] = x1 * cs[j] - x2 * sn[j]; acc[j + 8] = x1 * sn[j] + x2 * cs[j]; }
        }
        bf16_t* qp = Qb + tok * 384 + head * 96 + part * 32 + hf * 4;
#pragma unroll
        for (int g = 0; g < 4; ++g) { u32x2 o; o.x = pk2(acc[4 * g] * QS, acc[4 * g + 1] * QS); o.y = pk2(acc[4 * g + 2] * QS, acc[4 * g + 3] * QS); *(u32x2*)(qp + g * 8) = o; }
    }
}

DEV void mla_kv_item(const bf16_t* C, const float* gkv, const bf16_t* Wukv, bf16_t* Kb, bf16_t* VTb, int item, int lane) {
    const int n = lane & 31, hf = lane >> 5;
    const size_t tok = (size_t)item * 32 + n; const int pos = (int)(tok & (S - 1)); const int b = (int)(tok >> 13); const int tau = item & 255;
    const bf16_t* row = C + tok * CP + B_CKV + hf * 8;
    bf16x8 xf[8]; float ss = 0.f;
#pragma unroll
    for (int ks = 0; ks < 8; ++ks) { xf[ks] = *(const bf16x8*)(row + ks * 16);
#pragma unroll
        for (int e = 0; e < 8; ++e) { const float v = bf2f((bf16_t)xf[ks][e]); ss += v * v; } }
    ss += __shfl_xor(ss, 32);
    const float rs = rsqrtf(ss * (1.0f / 128.0f) + 1e-6f);
#pragma unroll
    for (int ks = 0; ks < 8; ++ks) { const f32x4 g0 = *(const f32x4*)(gkv + ks * 16 + hf * 8), g1 = *(const f32x4*)(gkv + ks * 16 + hf * 8 + 4);
        float v[8];
#pragma unroll
        for (int e = 0; e < 8; ++e) v[e] = bf2f((bf16_t)xf[ks][e]) * rs * (e < 4 ? g0[e] : g1[e - 4]);
        xf[ks] = pack8(v[0], v[1], v[2], v[3], v[4], v[5], v[6], v[7]); }
    {
        const bf16x8 k1 = *(const bf16x8*)(C + tok * CP + B_KPE + hf * 8), k2 = *(const bf16x8*)(C + tok * CP + B_KPE + 16 + hf * 8);
        float o1[8], o2[8];
#pragma unroll
        for (int e = 0; e < 8; ++e) { float cs, sn; rope_cs(pos, 8 * hf + e, cs, sn); const float x1 = bf2f((bf16_t)k1[e]), x2 = bf2f((bf16_t)k2[e]); o1[e] = x1 * cs - x2 * sn; o2[e] = x1 * sn + x2 * cs; }
        const bf16x8 p1 = pack8(o1[0], o1[1], o1[2], o1[3], o1[4], o1[5], o1[6], o1[7]), p2 = pack8(o2[0], o2[1], o2[2], o2[3], o2[4], o2[5], o2[6], o2[7]);
#pragma unroll
        for (int h = 0; h < 4; ++h) { bf16_t* kt_ = Kb + ((size_t)(b * 4 + h) * 256 + tau) * 3072 + lane * 8; *(bf16x8*)(kt_ + 4 * 512) = p1; *(bf16x8*)(kt_ + 5 * 512) = p2; }
    }
#pragma unroll 1
    for (int c = 0; c < 16; ++c) {
        const int head = c >> 2, part = c & 3;
        f32x16 acc = zero16();
        const bf16_t* wr_ = Wukv + (size_t)(c * 32 + n) * 128 + hf * 8;
#pragma unroll
        for (int ks = 0; ks < 8; ++ks) acc = MFMA32(*(const bf16x8*)(wr_ + ks * 16), xf[ks], acc);
        if (part < 2) {
            bf16_t* kp = Kb + ((size_t)(b * 4 + head) * 256 + tau) * 3072 + n * 8 + 4 * hf;
#pragma unroll
            for (int g = 0; g < 4; ++g) { u32x2 o; o.x = pk2(acc[4 * g], acc[4 * g + 1]); o.y = pk2(acc[4 * g + 2], acc[4 * g + 3]); *(u32x2*)(kp + (part * 2 + (g >> 1)) * 512 + (g & 1) * 256) = o; }
        } else {
            bf16_t* vp = VTb + (((size_t)(b * 4 + head) * 256 + tau) * 4 + (part - 2) * 2 + (n >> 4)) * 512 + ((n >> 2) & 1) * 256 + ((n >> 3) & 1) * 4 + (n & 3);
#pragma unroll
            for (int j = 0; j < 16; ++j) vp[kap(j, hf) * 8] = (bf16_t)(pk2(acc[j], 0.f) & 0xffffu);
        }
    }
}

DEV void vtrans_item(const bf16_t* src  , int tbase, int tstride, bf16_t* dst, size_t rowlen, int lane) {
    const bf16_t* row = src + (size_t)(tbase + lane * tstride) * CP;
    bf16_t* d = dst + lane;
#pragma unroll 2
    for (int i = 0; i < 8; ++i) {
        const bf16x8 v = *(const bf16x8*)(row + i * 8);
#pragma unroll
        for (int e = 0; e < 8; ++e) d[(size_t)e * rowlen] = (bf16_t)v[e];
        d += 8 * rowlen;
    }
}
DEV void vfrag_item(const bf16_t* src  , int tbase, int tstride, bf16_t* dst, int lane) {
    const int n = lane & 31, hf = lane >> 5;
#pragma unroll
    for (int qq = 0; qq < 2; ++qq) {
        bf16_t v[2][8];
#pragma unroll
        for (int e = 0; e < 8; ++e) { const int kp_ = qq * 16 + (e >> 2) * 8 + hf * 4 + (e & 3);
            const bf16_t* row = src + (size_t)(tbase + kp_ * tstride) * CP + n;
            v[0][e] = row[0]; v[1][e] = row[32]; }
#pragma unroll
        for (int d = 0; d < 2; ++d) { u32x4 w; w.x = v[d][0] | ((unsigned)v[d][1] << 16); w.y = v[d][2] | ((unsigned)v[d][3] << 16); w.z = v[d][4] | ((unsigned)v[d][5] << 16); w.w = v[d][6] | ((unsigned)v[d][7] << 16);
            *(u32x4*)(dst + (d * 2 + qq) * 512 + lane * 8) = w; }
    }
}
DEV void kfrag_item(const bf16_t* src, int tbase, bf16_t* dst, int lane) {
    const int n = lane & 31, hf = lane >> 5;
    const bf16_t* row = src + (size_t)(tbase + n) * CP + hf * 8;
#pragma unroll
    for (int ks = 0; ks < 4; ++ks) *(bf16x8*)(dst + ks * 512 + lane * 8) = *(const bf16x8*)(row + ks * 16);
}

DEV void compress_item(const Params& p, unsigned char* ws, int l, int item, LAS float* part, const int tid) {
    const bf16_t* C = (const bf16_t*)(ws + WS_C);
    const int w = tid >> 6, lane = tid & 63, n = lane & 31, hf = lane >> 5;
    const int b = item >> 5, kv = (item >> 4) & 1, ntile = item & 15;
    const int nrow = ntile * 32 + n;
    const bf16_t* W1 = (const bf16_t*)(ws + (size_t)l * W_LAYER + W_W1) + (size_t)kv * 128 * 2048;
    const bf16_t* W2 = (const bf16_t*)(ws + (size_t)l * W_LAYER + W_W2) + (size_t)kv * 64 * 128;
    const float* pe = p.in[7] + (size_t)(l * 2 + kv) * 32 * 64;
    const float* b1 = p.in[9] + (size_t)(l * 2 + kv) * 128;
    const float* b2 = p.in[11] + (size_t)(l * 2 + kv) * 64;
    const int ccol = kv ? C_VC : C_KC;
    f32x16 acc[4];
#pragma unroll
    for (int hc = 0; hc < 4; ++hc) acc[hc] = zero16();
#pragma unroll 1
    for (int li = 0; li < 4; ++li) {
        const int lpos = w * 4 + li;
        int tk = nrow * 16 + lpos; tk = tk < S ? tk : S - 1;
        const bf16_t* trow = C + ((size_t)b * S + tk) * CP + ccol + hf * 8;
        const float* prow = pe + lpos * 64 + hf * 8;
#pragma unroll 1
        for (int ks = 0; ks < 4; ++ks) {
            const bf16x8 tv = *(const bf16x8*)(trow + ks * 16);
            const f32x4 p0 = *(const f32x4*)(prow + ks * 16), p1 = *(const f32x4*)(prow + ks * 16 + 4);
            const bf16x8 xb = pack8(bf2f((bf16_t)tv[0]) + p0[0], bf2f((bf16_t)tv[1]) + p0[1], bf2f((bf16_t)tv[2]) + p0[2], bf2f((bf16_t)tv[3]) + p0[3],
                                    bf2f((bf16_t)tv[4]) + p1[0], bf2f((bf16_t)tv[5]) + p1[1], bf2f((bf16_t)tv[6]) + p1[2], bf2f((bf16_t)tv[7]) + p1[3]);
#pragma unroll
            for (int hc = 0; hc < 4; ++hc) acc[hc] = MFMA32(*(const bf16x8*)(W1 + (size_t)(hc * 32 + n) * 2048 + lpos * 64 + ks * 16 + hf * 8), xb, acc[hc]);
        }
    }
#pragma unroll
    for (int hc = 0; hc < 4; ++hc)
#pragma unroll
        for (int j = 0; j < 16; ++j) part[(w * 128 + hc * 32 + kap(j, hf)) * 32 + n] = acc[hc][j];
    __syncthreads();
#pragma unroll 1
    for (int i = 0; i < 8; ++i) { const int e = tid + 512 * i; float s = 0.f;
#pragma unroll
        for (int ww = 0; ww < 8; ++ww) s += part[ww * 4096 + e];
        s += b1[e >> 5];
        const float u = 0.7978845608028654f * (s + 0.044715f * s * s * s);
        const float th = 1.f - 2.f * rcp(1.f + ex2(2.f * LOG2E * u));
        part[e] = 0.5f * s * (1.f + th); }
    __syncthreads();
    if (w < 2) {
        f32x16 a2 = zero16();
#pragma unroll
        for (int ks = 0; ks < 8; ++ks) {
            float h[8];
#pragma unroll
            for (int e = 0; e < 8; ++e) h[e] = part[(ks * 16 + hf * 8 + e) * 32 + n];
            a2 = MFMA32(*(const bf16x8*)(W2 + (size_t)(w * 32 + n) * 128 + ks * 16 + hf * 8), pack8(h[0], h[1], h[2], h[3], h[4], h[5], h[6], h[7]), a2);
        }
        if (kv == 0) {
            bf16_t* kp = (bf16_t*)(ws + R_KCMP) + ((size_t)b * 16 + ntile) * 2048 + n * 8 + 4 * hf;
#pragma unroll
            for (int g = 0; g < 4; ++g) { const f32x4 bb = *(const f32x4*)(b2 + w * 32 + g * 8 + hf * 4);
                u32x2 o; o.x = pk2(a2[4 * g] + bb[0], a2[4 * g + 1] + bb[1]); o.y = pk2(a2[4 * g + 2] + bb[2], a2[4 * g + 3] + bb[3]); *(u32x2*)(kp + (w * 2 + (g >> 1)) * 512 + (g & 1) * 256) = o; }
        } else {
            bf16_t* vp = (bf16_t*)(ws + R_VTCMP) + (((size_t)b * 16 + ntile) * 4 + w * 2 + (n >> 4)) * 512 + ((n >> 2) & 1) * 256 + ((n >> 3) & 1) * 4 + (n & 3);
#pragma unroll
            for (int j = 0; j < 16; ++j) { const int r = kap(j, hf); vp[r * 8] = (bf16_t)(pk2(a2[j] + b2[w * 32 + r], 0.f) & 0xffffu); }
        }
    }
    __syncthreads();
}

template <int NK> DEV f32x16 qk_tile(const bf16x8 (&qf)[NK], const bf16_t* krow) {
    f32x16 s = zero16();
#pragma unroll
    for (int ks = 0; ks < NK; ++ks) s = MFMA32(*(const bf16x8*)(krow + ks * 16), qf[ks], s);
    return s;
}
DEV void pv_tile(f32x16 (&O)[2], const f32x16& p, const bf16_t* vt, size_t dv32) {
    const bf16x8 pf0 = pack8(p[0], p[1], p[2], p[3], p[4], p[5], p[6], p[7]), pf1 = pack8(p[8], p[9], p[10], p[11], p[12], p[13], p[14], p[15]);
#pragma unroll
    for (int d = 0; d < 2; ++d) { const bf16_t* r = vt + d * dv32;
        const s16x4 a0 = *(const s16x4*)(r), a1 = *(const s16x4*)(r + 8), a2 = *(const s16x4*)(r + 16), a3 = *(const s16x4*)(r + 24);
        const bf16x8 v0 = __builtin_shufflevector(a0, a1, 0, 1, 2, 3, 4, 5, 6, 7), v1 = __builtin_shufflevector(a2, a3, 0, 1, 2, 3, 4, 5, 6, 7);
        O[d] = MFMA32(v0, pf0, O[d]); O[d] = MFMA32(v1, pf1, O[d]); }
}
template <int NK> struct KVF { bf16x8 k[NK]; bf16x8 v[2][2]; };
template <int NK, int KS, bool LV> DEV void load_kv(KVF<NK>& f, const bf16_t* kp, const bf16_t* vp) {
#pragma unroll
    for (int ks = 0; ks < NK; ++ks) f.k[ks] = *(const bf16x8*)(kp + ks * KS);
    if (LV) {
#pragma unroll
        for (int d = 0; d < 2; ++d)
#pragma unroll
            for (int qq = 0; qq < 2; ++qq) f.v[d][qq] = *(const bf16x8*)(vp + (d * 2 + qq) * 512);
    }
}
template <int NK> DEV f32x16 qk_frag(const bf16x8 (&qf)[NK], const KVF<NK>& f) {
    f32x16 s = zero16();
#pragma unroll
    for (int ks = 0; ks < NK; ++ks) s = MFMA32(f.k[ks], qf[ks], s);
    return s;
}
template <int NK> DEV void pv_frag(f32x16 (&O)[2], const f32x16& p, const KVF<NK>& f) {
    const bf16x8 pf0 = pack8(p[0], p[1], p[2], p[3], p[4], p[5], p[6], p[7]), pf1 = pack8(p[8], p[9], p[10], p[11], p[12], p[13], p[14], p[15]);
#pragma unroll
    for (int d = 0; d < 2; ++d) { O[d] = MFMA32(f.v[d][0], pf0, O[d]); O[d] = MFMA32(f.v[d][1], pf1, O[d]); }
}
template <int NK, int KS, bool LV, class Addr, class Step>
DEV void tile_loop(int t0, int t1, Addr addr, Step step) {
    if (t0 >= t1) return;
    const int tl = t1 - 1;
    KVF<NK> A, B;
    { const bf16_t* kp; const bf16_t* vp; addr(t0, kp, vp); load_kv<NK, KS, LV>(A, kp, vp); }
    { const bf16_t* kp; const bf16_t* vp; addr(t0 + 1 < tl ? t0 + 1 : tl, kp, vp); load_kv<NK, KS, LV>(B, kp, vp); }
    int t = t0;
#pragma unroll 1
    for (; t + 1 < t1; t += 2) {
        step(A, t);
        { const bf16_t* kp; const bf16_t* vp; addr(t + 2 < tl ? t + 2 : tl, kp, vp); load_kv<NK, KS, LV>(A, kp, vp); }
        step(B, t + 1);
        { const bf16_t* kp; const bf16_t* vp; addr(t + 3 < tl ? t + 3 : tl, kp, vp); load_kv<NK, KS, LV>(B, kp, vp); }
    }
    if (t < t1) step(A, t);
}
constexpr float RESCALE_THR = 11.5f;
template <bool LAZY = true> DEV void softmax_update(f32x16& s, float& m, float& l, f32x16 (&O)[2]) {
    float mx = s[0];
#pragma unroll
    for (int j = 1; j < 16; ++j) mx = fmaxf(mx, s[j]);
    mx = xhalf_max(mx);
    const float mn = fmaxf(m, mx);
    if (!LAZY || __builtin_amdgcn_ballot_w64(mx > m + RESCALE_THR) != 0ull) {
        const float al = ex2(m - mn); m = mn; l *= al; O[0] *= al; O[1] *= al;
    }
    float rs = 0.f;
#pragma unroll
    for (int j = 0; j < 16; ++j) { const float pj = ex2(s[j] - m); s[j] = pj; rs += pj; }
    rs = xhalf_sum(rs);
    l += rs;
}
DEV void write_gated(const f32x16 (&O)[2], float sc, bf16_t* gp) {
#pragma unroll
    for (int d = 0; d < 2; ++d)
#pragma unroll
        for (int g = 0; g < 4; ++g) { bf16_t* q = gp + d * 32 + g * 8; const u32x2 gv = *(const u32x2*)q;
            const float g0 = bflo(gv.x), g1 = bfhi(gv.x), g2 = bflo(gv.y), g3 = bfhi(gv.y);
            u32x2 o; o.x = pk2(O[d][4 * g] * sc * g0 * sigm(g0), O[d][4 * g + 1] * sc * g1 * sigm(g1)); o.y = pk2(O[d][4 * g + 2] * sc * g2 * sigm(g2), O[d][4 * g + 3] * sc * g3 * sigm(g3));
            *(u32x2*)q = o; }
}

template <int MODE = 0> DEV void mla_item(unsigned char* ws, int b, int h, int qt, int lane) {
    const int n = lane & 31, hf = lane >> 5;
    const bf16_t* Qb = (const bf16_t*)(ws + R_QB); const bf16_t* Kb = (const bf16_t*)(ws + R_KB); const bf16_t* VT = (const bf16_t*)(ws + R_VTB); bf16_t* C = (bf16_t*)(ws + WS_C);
    const size_t tok = (size_t)b * S + qt * 32 + n;
    bf16x8 qf[6];
#pragma unroll
    for (int ks = 0; ks < 6; ++ks) qf[ks] = *(const bf16x8*)(Qb + tok * 384 + h * 96 + hf * 8 + ks * 16);
    f32x16 O[2]; O[0] = zero16(); O[1] = zero16(); float m = NEG, l = 0.f;
    const bf16_t* kp0 = Kb + (size_t)(b * 4 + h) * 256 * 3072 + lane * 8;
    const bf16_t* vp0 = VT + (size_t)(b * 4 + h) * 256 * 2048 + lane * 8;
    tile_loop<6, 512, true>(0, qt + 1,
        [&](int t, const bf16_t*& kp, const bf16_t*& vp) { kp = kp0 + (size_t)t * 3072; vp = vp0 + (size_t)t * 2048; },
        [&](const KVF<6>& f, int t) {
            if (MODE == 3) { bf16x8 x = f.k[0];
#pragma unroll
                for (int ks = 1; ks < 6; ++ks) x ^= f.k[ks];
                x ^= f.v[0][0] ^ f.v[0][1] ^ f.v[1][0] ^ f.v[1][1]; O[0][0] += (float)x[0]; return; }
            f32x16 s = qk_frag<6>(qf, f);
            if (MODE == 2) { O[0] += s; return; }
            if (t == qt) {
#pragma unroll
                for (int j = 0; j < 16; ++j) if (kap(j, hf) > n) s[j] = NEG;
            }
            softmax_update<false>(s, m, l, O);
            pv_frag<6>(O, s, f);
        });
    if (MODE == 0) write_gated(O, rcp(l), C + tok * CP + B_G + h * 64 + hf * 4);
    else if (O[0][0] + O[1][3] + l == 1.2345e-20f) C[tok * CP + CP - 1] = 0;
}

template <int MODE = 0> DEV void sb_item(unsigned char* ws, int b, int h, int qt, int lane) {
    const int n = lane & 31, hf = lane >> 5;
    bf16_t* C = (bf16_t*)(ws + WS_C); const bf16_t* VT = (const bf16_t*)(ws + R_VTD);
    const size_t tok = (size_t)b * S + qt * 32 + n;
    bf16x8 qf[4];
#pragma unroll
    for (int ks = 0; ks < 4; ++ks) qf[ks] = *(const bf16x8*)(C + tok * CP + D_Q + h * 64 + hf * 8 + ks * 16);
    const float c = 0.125f * LOG2E;
    f32x16 O[2]; O[0] = zero16(); O[1] = zero16(); float carry = 0.f;
    const bf16_t* kp = C + ((size_t)b * S + n) * CP + D_K + h * 64 + hf * 8;
    const bf16_t* vp = VT + ((size_t)(b * 4 + h) * 64 + n) * S + hf * 4;
#pragma unroll 1
    for (int kt = qt; kt >= 0; --kt) {
        f32x16 s = qk_tile<4>(qf, kp + (size_t)kt * 32 * CP);
        f32x16 L;
#pragma unroll
        for (int j = 0; j < 16; ++j) { const float z = s[j] * c; const bool valid = (kt < qt) || (kap(j, hf) < n);
            const float sp = fmaxf(z, 0.f) + lg2(1.f + ex2(-fabsf(z)));
            L[j] = valid ? -sp : 0.f; s[j] = valid ? z : NEG; }
        float sg[4], pg[4];
#pragma unroll
        for (int g = 0; g < 4; ++g) { L[4 * g + 2] += L[4 * g + 3]; L[4 * g + 1] += L[4 * g + 2]; L[4 * g] += L[4 * g + 1]; sg[g] = L[4 * g]; }
#pragma unroll
        for (int g = 0; g < 4; ++g) pg[g] = xhalf_get(sg[g], hf);
        float run = carry;
#pragma unroll
        for (int g = 3; g >= 0; --g) { const float base = run + (hf == 0 ? pg[g] : 0.f);
#pragma unroll
            for (int i = 0; i < 4; ++i) s[4 * g + i] = ex2(s[4 * g + i] + base + L[4 * g + i]);
            run += sg[g] + pg[g]; }
        carry = run;
        pv_tile(O, s, vp + kt * 32, (size_t)32 * S);
        if (__builtin_amdgcn_ballot_w64(carry > -64.f) == 0ull) break;
    }
    if (MODE == 0) write_gated(O, 1.f, C + tok * CP + D_G + h * 64 + hf * 4);
    else if (O[0][0] + O[1][3] == 1.2345e-20f) C[tok * CP + CP - 1] = 0;
}

template <int MODE = 0> DEV void dsw_item(unsigned char* ws, int b, int h, int r, int ut, int lane) {
    const int n = lane & 31, hf = lane >> 5;
    bf16_t* C = (bf16_t*)(ws + WS_C);
    const int tq = r + 16 * (ut * 32 + n);
    const size_t tok = (size_t)b * S + tq;
    bf16x8 qf[4];
#pragma unroll
    for (int ks = 0; ks < 4; ++ks) qf[ks] = *(const bf16x8*)(C + tok * CP + A_Q + h * 64 + hf * 8 + ks * 16);
    const float c = 0.125f * LOG2E, sl2 = LOG2E * 0.5f / (float)(1 << (2 * h));
    f32x16 O[2]; O[0] = zero16(); O[1] = zero16(); float m = NEG, l = 0.f;
    const bf16_t* kb = C + (size_t)b * S * CP + A_K + h * 64 + hf * 8;
    const size_t vrow = (size_t)(b * 4 + h) * 256 * 2048 + lane * 8;
    {
        const bf16_t* vb = (const bf16_t*)(ws + R_VTA16) + vrow + (size_t)r * 16 * 2048;
        const int ub = ut * 32 - 128;
        tile_loop<4, 16, true>(ut < 4 ? 4 - ut : 0, 5,
            [&](int t, const bf16_t*& kp, const bf16_t*& vp) { const int us = ub + t * 32; kp = kb + (size_t)(r + 16 * (us + n)) * CP; vp = vb + (size_t)(us >> 5) * 2048; },
            [&](const KVF<4>& f, int t) { const int us = ub + t * 32; f32x16 s = qk_frag<4>(qf, f);
#pragma unroll
                for (int j = 0; j < 16; ++j) { const int dist = tq - (r + 16 * (us + kap(j, hf))); s[j] = (dist >= 0 && dist <= 2048) ? s[j] * c - sl2 * (float)dist : NEG; }
                softmax_update(s, m, l, O); pv_frag<4>(O, s, f); });
    }
    {
        const int r4 = r & 3;
        const bf16_t* vb = (const bf16_t*)(ws + R_VTA4) + vrow + (size_t)r4 * 64 * 2048;
        const int ub = ut * 128 - 128;
        tile_loop<4, 16, true>(ut == 0 ? 4 : 0, 8,
            [&](int t, const bf16_t*& kp, const bf16_t*& vp) { const int us = ub + t * 32; kp = kb + (size_t)(r4 + 4 * (us + n)) * CP; vp = vb + (size_t)(us >> 5) * 2048; },
            [&](const KVF<4>& f, int t) { const int us = ub + t * 32; f32x16 s = qk_frag<4>(qf, f);
#pragma unroll
                for (int j = 0; j < 16; ++j) { const int dist = tq - (r4 + 4 * (us + kap(j, hf))); s[j] = (dist >= 0 && dist <= 512) ? s[j] * c - sl2 * (float)dist : NEG; }
                softmax_update(s, m, l, O); pv_frag<4>(O, s, f); });
    }
    {
        const bf16_t* vb = (const bf16_t*)(ws + R_VTA1) + vrow;
        const int tb = ut * 512 - 128;
        const bf16_t* kf1 = (const bf16_t*)(ws + R_KFA1) + vrow;
        tile_loop<4, 512, true>(ut == 0 ? 4 : 0, 20,
            [&](int t, const bf16_t*& kp, const bf16_t*& vp) { const int ts = tb + t * 32; kp = kf1 + (size_t)(ts >> 5) * 2048; vp = vb + (size_t)(ts >> 5) * 2048; },
            [&](const KVF<4>& f, int t) { const int ts = tb + t * 32; f32x16 s = qk_frag<4>(qf, f);
#pragma unroll
                for (int j = 0; j < 16; ++j) { const int dist = tq - (ts + kap(j, hf)); s[j] = (dist >= 0 && dist <= 128) ? s[j] * c - sl2 * (float)dist : NEG; }
                softmax_update(s, m, l, O); pv_frag<4>(O, s, f); });
    }
    if (MODE == 0) write_gated(O, rcp(l), C + tok * CP + A_G + h * 64 + hf * 4);
    else if (O[0][0] + O[1][3] + l == 1.2345e-20f) C[tok * CP + CP - 1] = 0;
}

template <int MODE = 0> DEV void nsa_item(unsigned char* ws, int b, int q0, int lane, LAS float* Asel  , LAS float* Bsel  , LAS float* stash  ) {
    const int n = lane & 31, hf = lane >> 5, ql = n >> 2, hd = n & 3;
    bf16_t* C = (bf16_t*)(ws + WS_C);
    const int t = q0 + ql, tmax = q0 + 7;
    const size_t tok = (size_t)b * S + t;
    const float c = 0.125f * LOG2E, sl2 = LOG2E * 0.25f / (float)(1 << (2 * hd));
    bf16x8 qf[4];
#pragma unroll
    for (int ks = 0; ks < 4; ++ks) qf[ks] = *(const bf16x8*)(C + tok * CP + C_Q + hd * 64 + hf * 8 + ks * 16);
    float g0, g1, g2;
    { const bf16_t* gp = C + tok * CP + C_GT + hd * 3; g0 = sigm(bf2f(gp[0])); g1 = sigm(bf2f(gp[1])); g2 = sigm(bf2f(gp[2])); }
#pragma unroll
    for (int i = 0; i < 32; ++i) Asel[lane + 64 * i] = 0.f;
    {
        const int ntiles = (tmax >= 31) ? ((((tmax - 31) >> 4) >> 5) + 1) : 0;
        const bf16_t* kc = (const bf16_t*)(ws + R_KCMP) + (size_t)b * 16 * 2048 + lane * 8;
        const bf16_t* vc = (const bf16_t*)(ws + R_VTCMP) + (size_t)b * 16 * 2048 + lane * 8;
        float m = NEG, l = 0.f;
        auto addr = [&](int nt, const bf16_t*& kp, const bf16_t*& vp) { kp = kc + (size_t)nt * 2048; vp = vc + (size_t)nt * 2048; };
        tile_loop<4, 512, false>(0, ntiles, addr,
            [&](const KVF<4>& f, int nt) { f32x16 s = qk_frag<4>(qf, f);
                float mx = NEG;
#pragma unroll
                for (int j = 0; j < 16; ++j) { const int dist = t - (16 * (nt * 32 + kap(j, hf)) + 31); s[j] = dist >= 0 ? s[j] * c - sl2 * (float)dist : NEG; mx = fmaxf(mx, s[j]); }
                mx = xhalf_max(mx);
                const float mn = fmaxf(m, mx); float rs = 0.f;
#pragma unroll
                for (int j = 0; j < 16; ++j) rs += (s[j] > -1e29f) ? ex2(s[j] - mn) : 0.f;
                rs = xhalf_sum(rs);
                l = l * ex2(m - mn) + rs; m = mn; });
        const float il = l > 0.f ? 1.0f / l : 0.f;
        f32x16 Oc[2]; Oc[0] = zero16(); Oc[1] = zero16();
        tile_loop<4, 512, true>(0, ntiles, addr,
            [&](const KVF<4>& f, int nt) { f32x16 s = qk_frag<4>(qf, f);
#pragma unroll
                for (int j = 0; j < 16; ++j) { const int dist = t - (16 * (nt * 32 + kap(j, hf)) + 31); s[j] = dist >= 0 ? ex2(s[j] * c - sl2 * (float)dist - m) * il : 0.f; }
#pragma unroll
                for (int g = 0; g < 4; ++g) { float a = s[4 * g], bb = a + 2.f * (s[4 * g + 1] + s[4 * g + 2] + s[4 * g + 3]);
                    a += dpp_quad<0xB1>(a); a += dpp_quad<0x4E>(a); bb += dpp_quad<0xB1>(bb); bb += dpp_quad<0x4E>(bb);
                    if (hd == 0) { const int js = nt * 8 + 2 * g + hf; Asel[ql * 128 + js] = a; Bsel[ql * 128 + js] = bb; } }
                pv_frag<4>(Oc, s, f); });
#pragma unroll
        for (int d = 0; d < 2; ++d)
#pragma unroll
            for (int j = 0; j < 16; ++j) stash[(d * 16 + j) * 64 + lane] = Oc[d][j] * g0;
    }
    unsigned long long mylo = 0ull, myhi = 0ull, ulo = 0ull, uhi = 0ull;
#pragma unroll 1
    for (int q = 0; q < 8; ++q) {
        const int tq = q0 + q, cur = tq >> 6;
        LAS float* Aq = Asel + q * 128; LAS float* Bq = Bsel + q * 128;
        unsigned k0, k1; bool va0, va1;
        { const int j = lane; va0 = j * 64 <= tq; const bool forced = (j == 0) || (j == cur) || (j == cur - 1);
          const float ps = Aq[j] + (j > 0 ? Bq[j > 0 ? j - 1 : 0] : 0.f); const float sc = forced ? 1e9f : ps;
          k0 = va0 ? (((__builtin_bit_cast(unsigned, sc) >> 6) << 7) | (unsigned)(127 - j)) : 0u; }
        { const int j = lane + 64; va1 = j * 64 <= tq; const bool forced = (j == cur) || (j == cur - 1);
          const float ps = Aq[j] + Bq[j - 1]; const float sc = forced ? 1e9f : ps;
          k1 = va1 ? (((__builtin_bit_cast(unsigned, sc) >> 6) << 7) | (unsigned)(127 - j)) : 0u; }
        LAS unsigned* Kq = (LAS unsigned*)Aq;
        Kq[lane] = k0; Kq[lane + 64] = k1;
        int r0 = 0, r1 = 0;
#pragma unroll 8
        for (int jj = 0; jj < 128; jj += 4) { const u32x4 v = *(const LAS u32x4*)(Kq + jj);
#pragma unroll
            for (int e = 0; e < 4; ++e) { r0 += (v[e] > k0) ? 1 : 0; r1 += (v[e] > k1) ? 1 : 0; } }
        const unsigned long long lo = __builtin_amdgcn_ballot_w64(va0 && r0 < 16), hi = __builtin_amdgcn_ballot_w64(va1 && r1 < 16);
        ulo |= lo; uhi |= hi; if (ql == q) { mylo = lo; myhi = hi; }
    }
    if (MODE == 2) { if ((ulo ^ uhi ^ mylo) == 0x123456789abcdefull) C[tok * CP + CP - 1] = 0; return; }
    if (MODE != 3) {
        LAS int* list = (LAS int*)Asel;
        int ntl = 0;
#pragma unroll 1
        for (int w = 0; w < 2; ++w) {
            unsigned long long um = w ? uhi : ulo;
            while (um) { const int bit = __builtin_ctzll(um); um &= um - 1ull; const int ts = (bit + 64 * w) * 64;
                if (ts <= tmax) { list[ntl++] = ts; if (ts + 32 <= tmax) list[ntl++] = ts + 32; } }
        }
        f32x16 O[2]; O[0] = zero16(); O[1] = zero16(); float m = NEG, l = 0.f;
        const bf16_t* kb = (const bf16_t*)(ws + R_KFCS) + (size_t)b * 256 * 2048 + lane * 8;
        const bf16_t* vb = (const bf16_t*)(ws + R_VTCS) + (size_t)b * 256 * 2048 + lane * 8;
        tile_loop<4, 512, true>(0, ntl,
            [&](int i, const bf16_t*& kp, const bf16_t*& vp) { const int ts = __builtin_amdgcn_readfirstlane(list[i]); kp = kb + (size_t)(ts >> 5) * 2048; vp = vb + (size_t)(ts >> 5) * 2048; },
            [&](const KVF<4>& f, int i) { const int ts = __builtin_amdgcn_readfirstlane(list[i]); const int jb = ts >> 6;
                const bool mysel = ((jb < 64 ? (mylo >> jb) : (myhi >> (jb - 64))) & 1ull) != 0ull;
                f32x16 s = qk_frag<4>(qf, f);
                if (ts + 31 <= q0) {
                    const float bt = mysel ? -sl2 * (float)(t - ts - 4 * hf) : NEG;
#pragma unroll
                    for (int j = 0; j < 16; ++j) s[j] = fmaf(s[j], c, fmaf((float)(8 * (j >> 2) + (j & 3)), sl2, bt));
                } else {
#pragma unroll
                    for (int j = 0; j < 16; ++j) { const int dist = t - (ts + kap(j, hf)); s[j] = (mysel && dist >= 0) ? s[j] * c - sl2 * (float)dist : NEG; }
                }
                softmax_update(s, m, l, O); pv_frag<4>(O, s, f); });
        const float sc = g1 * rcp(l);
#pragma unroll
        for (int d = 0; d < 2; ++d)
#pragma unroll
            for (int j = 0; j < 16; ++j) stash[(d * 16 + j) * 64 + lane] += O[d][j] * sc;
    }
    {
        f32x16 O[2]; O[0] = zero16(); O[1] = zero16(); float m = NEG, l = 0.f;
        const bf16_t* kb = (const bf16_t*)(ws + R_KFCW) + (size_t)b * 256 * 2048 + lane * 8;
        const bf16_t* vb = (const bf16_t*)(ws + R_VTCW) + (size_t)b * 256 * 2048 + lane * 8;
        const int ws0 = (q0 > 511 ? q0 - 511 : 0) & ~31;
        tile_loop<4, 512, true>(0, ((tmax - ws0) >> 5) + 1,
            [&](int i, const bf16_t*& kp, const bf16_t*& vp) { const int ts = ws0 + i * 32; kp = kb + (size_t)(ts >> 5) * 2048; vp = vb + (size_t)(ts >> 5) * 2048; },
            [&](const KVF<4>& f, int i) { const int ts = ws0 + i * 32; f32x16 s = qk_frag<4>(qf, f);
                if (ts + 31 <= q0 && ts >= q0 - 504) {
                    const float bt = -sl2 * (float)(t - ts - 4 * hf);
#pragma unroll
                    for (int j = 0; j < 16; ++j) s[j] = fmaf(s[j], c, fmaf((float)(8 * (j >> 2) + (j & 3)), sl2, bt));
                } else {
#pragma unroll
                    for (int j = 0; j < 16; ++j) { const int dist = t - (ts + kap(j, hf)); s[j] = (dist >= 0 && dist < 512) ? s[j] * c - sl2 * (float)dist : NEG; }
                }
                softmax_update(s, m, l, O); pv_frag<4>(O, s, f); });
        const float sc = g2 * rcp(l);
#pragma unroll
        for (int d = 0; d < 2; ++d)
#pragma unroll
            for (int j = 0; j < 16; ++j) O[d][j] = O[d][j] * sc + stash[(d * 16 + j) * 64 + lane];
        if (MODE == 0) write_gated(O, 1.f, C + tok * CP + C_G + hd * 64 + hf * 4);
        else if (O[0][0] + O[1][3] == 1.2345e-20f) C[tok * CP + CP - 1] = 0;
    }
}


#define XB_TMO      128
#define XB_XCNT(j)  (256  + 64 * (j))
#define XB_XSUB(j)  (1280 + 64 * (j))
#define XB_XGEN(j)  (2304 + 64 * (j))
#define XB_TOP      3328
#define XB_TOPGEN   3392
#define XCD_BAR_WORDS 3456
#define XB_SPIN_CAP (1u << 18)
DEV unsigned xb_ld(unsigned* p)              { return __hip_atomic_load(p, __ATOMIC_RELAXED, __HIP_MEMORY_SCOPE_AGENT); }
DEV unsigned xb_add(unsigned* p, unsigned v) { return __hip_atomic_fetch_add(p, v, __ATOMIC_RELAXED, __HIP_MEMORY_SCOPE_AGENT); }
DEV unsigned xb_xcc_id() { return (unsigned)__builtin_amdgcn_s_getreg((3 << 11) | 20) & 0xFu; }
#define XB_SPIN(cond, bar) do { unsigned _sp = 0; while (cond) { __builtin_amdgcn_s_sleep(1); \
    if ((++_sp & 255u) == 0u) { if (xb_ld(&(bar)[XB_TMO])) break; if (_sp > XB_SPIN_CAP) { atomicAdd(&(bar)[XB_TMO], 1u); break; } } } } while (0)
struct XcdBarrier { unsigned* bar; unsigned x; volatile LAS unsigned* st; };
DEV XcdBarrier xcd_barrier_post(unsigned* bar, volatile LAS unsigned* st) {
    XcdBarrier b; b.bar = bar; b.x = xb_xcc_id(); b.st = st;
    if (threadIdx.x == 0) (void)xb_add(&bar[XB_XCNT(b.x)], 1u);
    return b;
}
DEV void xcd_barrier_complete(unsigned* bar, unsigned x, unsigned& nloc, unsigned& nx) {
    const unsigned G = gridDim.x * gridDim.y * gridDim.z;
    unsigned sum, cnt, mine, sp = 0u;
    for (;;) {
        sum = 0u; cnt = 0u; mine = 0u;
#pragma unroll
        for (unsigned j = 0; j < 16; ++j) { const unsigned c = xb_ld(&bar[XB_XCNT(j)]); sum += c; cnt += (c > 0u) ? 1u : 0u; mine = (j == x) ? c : mine; }
        if (sum == G) break;
        __builtin_amdgcn_s_sleep(1);
        if ((++sp & 255u) == 0u) { if (xb_ld(&bar[XB_TMO])) break; if (sp > XB_SPIN_CAP) { atomicAdd(&bar[XB_TMO], 1u); break; } }
    }
    nloc = mine > 0u ? mine : 1u; nx = cnt > 0u ? cnt : 1u;
}
DEV void xcd_barrier(const XcdBarrier& b) {
    asm volatile("s_waitcnt vmcnt(0)" ::: "memory");
    __syncthreads();
    if (threadIdx.x == 0) {
        unsigned* bar = b.bar;
        __builtin_amdgcn_s_waitcnt(0);
        unsigned nloc = b.st[0], nx = b.st[1];
        if (nloc == 0u) { xcd_barrier_complete(bar, b.x, nloc, nx); b.st[0] = nloc; b.st[1] = nx; }
        const unsigned old = xb_add(&bar[XB_XSUB(b.x)], 1u);
        const unsigned gen = old / nloc;
        if (old + 1u == (gen + 1u) * nloc) {
            __builtin_amdgcn_fence(__ATOMIC_RELEASE, "agent");
            asm volatile("s_waitcnt vmcnt(0)" ::: "memory");
            const unsigned og = xb_add(&bar[XB_TOP], 1u);
            const unsigned tg = og / nx;
            if (og + 1u == (tg + 1u) * nx) xb_add(&bar[XB_TOPGEN], 1u);
            else XB_SPIN(xb_ld(&bar[XB_TOPGEN]) == tg, bar);
            __builtin_amdgcn_fence(__ATOMIC_ACQUIRE, "agent");
            xb_add(&bar[XB_XGEN(b.x)], 1u);
            asm volatile("s_waitcnt vmcnt(0)" ::: "memory");
        } else {
            XB_SPIN(xb_ld(&bar[XB_XGEN(b.x)]) == gen, bar);
            __builtin_amdgcn_fence(__ATOMIC_ACQUIRE, "agent");
            asm volatile("s_waitcnt vmcnt(0)" ::: "memory");
        }
    }
    __syncthreads();
}

#define FRESH() int tid = threadIdx.x; asm volatile("" : "+v"(tid)); size_t zoff_ = 0; asm volatile("" : "+s"(zoff_)); unsigned char* ws = p.ws + zoff_; \
    const int lane = tid & 63, wv = __builtin_amdgcn_readfirstlane(tid >> 6), gw = cb * 8 + wv; (void)lane; (void)gw; (void)ws;
__global__ void __launch_bounds__(512, 2) mega(Params p) {
    extern __shared__ __attribute__((aligned(16))) unsigned char smem[];
    cg::grid_group grid = cg::this_grid();
    LAS unsigned char* lds = (LAS unsigned char*)smem;
    const int G = gridDim.x, cb = blockIdx.x, nW = G * 8;
    volatile LAS unsigned* xst = (volatile LAS unsigned*)(lds + LDS_RING);
    if (threadIdx.x == 0) { xst[0] = 0u; xst[1] = 0u; }
    __syncthreads();
    const XcdBarrier xb = xcd_barrier_post((unsigned*)(p.ws + WS_BAR), xst);
    for (int ph = p.ph_lo; ph < p.ph_hi; ++ph) {
        if (ph > p.ph_lo) xcd_barrier(xb);
        if (p.ph_hi < 0) grid.sync();
        const int l = (ph >= 7) ? 1 : 0;
        const int lp = (ph == 0) ? 0 : (ph <= 5 ? ph : (ph == 6 ? 0 : (ph <= 11 ? ph - 6 : 12)));
        const size_t wlo = (size_t)l * W_LAYER;
#ifdef DBL_MASK
        const int reps = (((DBL_MASK) >> lp) & 1) ? 2 : 1;
#else
        const int reps = 1;
#endif
        for (int rep = 0; rep < reps; ++rep) {
        if (ph == 0) {
            { FRESH(); for (int i = cb; i < 2 * TJ_LAYER; i += G) { TJob j; make_tjob(p, ws, i, j); transpose_tile(j, (LAS float*)lds, tid); } }
            { FRESH(); rmsnorm_rows_bf16(p.in[0], p.in[1], (bf16_t*)(ws + WS_H), gw, nW, lane); }
        } else if (ph == 6) {
            FRESH(); rmsnorm_rows_bf16(p.out, p.in[1] + 1024, (bf16_t*)(ws + WS_H), gw, nW, lane);
        } else if (lp == 12) {
            FRESH(); rmsnorm_rows_f32(p.out, p.in[16], gw, nW, lane);
        } else if (lp == 1) {
            FRESH();
            pg8::SchedIn Sd{(const char*)(ws + WS_H), (const char*)(ws + wlo + W_IN), G, cb};
            pg8::EpiIn E{(bf16_t*)(ws + WS_C)};
            pg8::gemm_phase(lds, Sd, E, tid);
        } else if (lp == 2) {
#ifndef SK_CMP
            { FRESH(); for (int i = G - 1 - cb; i < 128; i += G) compress_item(p, ws, l, i, (LAS float*)lds, tid); }
#endif
#ifndef SK_Q
            { FRESH(); for (int i = gw; i < 1024; i += nW) mla_q_item((const bf16_t*)(ws + WS_C), p.in[3] + l * 192, (const bf16_t*)(ws + wlo + W_UQ), (bf16_t*)(ws + R_QB), i, lane); }
#endif
#ifndef SK_KV
            { FRESH(); for (int i = nW - 1 - gw; i < 1024; i += nW) mla_kv_item((const bf16_t*)(ws + WS_C), p.in[5] + l * 128, (const bf16_t*)(ws + wlo + W_UKV), (bf16_t*)(ws + R_KB), (bf16_t*)(ws + R_VTB), i, lane); }
#endif
#ifndef SK_VT
            { FRESH(); const bf16_t* C = (const bf16_t*)(ws + WS_C);
            for (int i = gw; i < 3 * 16 * 256 + 16 * 128 + 4 * 4 * 256 + 16 * 256; i += nW) {
                if (i < 3 * 16 * 256) {
                    const int kind = i >> 12, bh = (i >> 8) & 15, tl = i & 255; const int b = bh >> 2, h = bh & 3;
                    const bf16_t* src = C + (size_t)b * S * CP + A_V + h * 64;
                    bf16_t* dst = (bf16_t*)(ws + (kind == 0 ? R_VTA1 : kind == 1 ? R_VTA4 : R_VTA16)) + ((size_t)bh * 256 + tl) * 2048;
                    if (kind == 0) vfrag_item(src, tl * 32, 1, dst, lane);
                    else if (kind == 1) { const int r4 = tl >> 6, u0 = (tl & 63) * 32; vfrag_item(src, r4 + 4 * u0, 4, dst, lane); }
                    else { const int r16 = tl >> 4, u0 = (tl & 15) * 32; vfrag_item(src, r16 + 16 * u0, 16, dst, lane); }
                } else if (i < 3 * 16 * 256 + 16 * 128) {
                    const int k = i - 3 * 16 * 256; const int bh = k >> 7, tl = k & 127; const int b = bh >> 2, h = bh & 3;
                    vtrans_item(C + (size_t)b * S * CP + D_V + h * 64, tl * 64, 1, (bf16_t*)(ws + R_VTD) + (size_t)bh * 64 * S + tl * 64, S, lane);
                } else if (i >= 3 * 16 * 256 + 16 * 128 + 4 * 4 * 256) {
                    const int k = i - (3 * 16 * 256 + 16 * 128 + 4 * 4 * 256); const int bh = k >> 8, tl = k & 255;
                    kfrag_item(C + (size_t)(bh >> 2) * S * CP + A_K + (bh & 3) * 64, tl * 32, (bf16_t*)(ws + R_KFA1) + ((size_t)bh * 256 + tl) * 2048, lane);
                } else {
                    const int k = i - (3 * 16 * 256 + 16 * 128); const int kind = k >> 10, b = (k >> 8) & 3, tl = k & 255;
                    const bf16_t* src = C + (size_t)b * S * CP + (kind == 0 ? C_VS : kind == 1 ? C_VW : kind == 2 ? C_KS : C_KW);
                    bf16_t* dst = (bf16_t*)(ws + (kind == 0 ? R_VTCS : kind == 1 ? R_VTCW : kind == 2 ? R_KFCS : R_KFCW)) + ((size_t)b * 256 + tl) * 2048;
                    if (kind < 2) vfrag_item(src, tl * 32, 1, dst, lane); else kfrag_item(src, tl * 32, dst, lane);
                }
            } }
#endif
        } else if (lp == 3) {
#ifndef SK_MLA
            { FRESH(); for (int k = 0; k * G < 512; ++k) { const int g = k * G + ((k & 1) ? G - 1 - cb : cb); if (g >= 512) continue;
                const int qt8 = 31 - (g >> 4), bh = g & 15;
#ifdef EXP_MLA
                mla_item<EXP_MLA>(ws, bh >> 2, bh & 3, qt8 * 8 + wv, lane);
#endif
                mla_item(ws, bh >> 2, bh & 3, qt8 * 8 + wv, lane); } }
#endif
#ifndef SK_NSA
            { FRESH(); for (int k = 0; k * G < 512; ++k) { const int g = k * G + ((k & 1) ? G - 1 - cb : cb); if (g >= 512) continue;
                const int qg = 127 - (g >> 2), b = g & 3; LAS float* As = (LAS float*)lds + wv * 4096;
#ifdef EXP_NSA
                nsa_item<EXP_NSA>(ws, b, qg * 64 + wv * 8, lane, As, As + 1024, As + 2048);
#endif
                nsa_item(ws, b, qg * 64 + wv * 8, lane, As, As + 1024, As + 2048); } }
#endif
#ifndef SK_DSW
            { FRESH(); for (int k = 0; k * G < 512; ++k) { const int g = k * G + ((k & 1) ? G - 1 - cb : cb); if (g >= 512) continue;
                const int bh = g & 15, ut = (g >> 4) & 15, oc = g >> 8;
#ifdef EXP_DSW
                dsw_item<1>(ws, bh >> 2, bh & 3, oc * 8 + wv, ut, lane);
#endif
                dsw_item(ws, bh >> 2, bh & 3, oc * 8 + wv, ut, lane); } }
#endif
#ifndef SK_SB
            { FRESH(); for (int k = 0; k * G < 512; ++k) { const int g = k * G + ((k & 1) ? G - 1 - cb : cb); if (g >= 512) continue;
                const int qt8 = 31 - (g >> 4), bh = g & 15;
#ifdef EXP_SB
                sb_item<1>(ws, bh >> 2, bh & 3, qt8 * 8 + wv, lane);
#endif
                sb_item(ws, bh >> 2, bh & 3, qt8 * 8 + wv, lane); } }
#endif
        } else if (lp == 4) {
            FRESH();
            pg8::SchedMerge Sd{(const char*)(ws + WS_H), (const char*)(ws + WS_C), (const char*)(ws + wlo + W_MG), (const char*)(ws + wlo + W_BR), G, cb};
            pg8::EpiMerge E{p.in[14] + (size_t)l * 4096, (bf16_t*)(ws + R_GS) + (size_t)cb * 65536, (bf16_t*)(ws + R_MACC) + (size_t)cb * 65536, (bf16_t*)(ws + R_MB)};
            pg8::gemm_phase(lds, Sd, E, tid);
        } else if (lp == 5) {
            FRESH();
            pg8::SchedOut Sd{(const char*)(ws + R_MB), (const char*)(ws + wlo + W_OUT), G, cb};
            pg8::EpiOut E{l == 0 ? p.in[0] : (const float*)p.out, p.out};
            pg8::gemm_phase(lds, Sd, E, tid);
        }
        __syncthreads();
        }
    }
#ifdef DBG_K
    {
        asm volatile("s_waitcnt vmcnt(0) lgkmcnt(0)" ::: "memory");
        __syncthreads();
        if (threadIdx.x < 64) { __builtin_amdgcn_fence(__ATOMIC_RELEASE, "agent"); asm volatile("s_waitcnt vmcnt(0)" ::: "memory"); }
        grid.sync();
        __builtin_amdgcn_fence(__ATOMIC_ACQUIRE, "agent"); asm volatile("s_waitcnt vmcnt(0)" ::: "memory");
        const bf16_t* src = (const bf16_t*)(p.ws + DBG_OFF);
        const size_t nel = (size_t)(DBG_BYTES) / 2, NO = (size_t)T * 1024;
        for (size_t i = (size_t)blockIdx.x * 512 + threadIdx.x; i < NO; i += (size_t)gridDim.x * 512) {
            float s = 0.f;
            for (size_t k = i; k < nel; k += NO) s += bf2f(src[k]);
            p.out[i] = s;
        }
    }
#endif
}

extern "C" void kernel_launch(void* const* d_in, const int* in_sizes, int n_in, void* d_out, int out_size, void* d_ws, size_t ws_size, hipStream_t stream) {
    static int grid_blocks = 0;
    if (!grid_blocks) {
        if (hipFuncSetAttribute((const void*)mega, hipFuncAttributeMaxDynamicSharedMemorySize, LDS_BYTES) != hipSuccess) { fprintf(stderr, "hipFuncSetAttribute failed\n"); return; }
        int dev = 0, cus = 0, per_cu = 0;
        hipGetDevice(&dev);
        hipDeviceGetAttribute(&cus, hipDeviceAttributeMultiprocessorCount, dev);
        hipOccupancyMaxActiveBlocksPerMultiprocessor(&per_cu, mega, 512, LDS_BYTES);
        if (per_cu < 1) { fprintf(stderr, "occupancy query returned %d\n", per_cu); return; }
        grid_blocks = cus;
        if (grid_blocks > 256) grid_blocks = 256;
    }
    if (ws_size < WS_TOTAL) { fprintf(stderr, "workspace too small: %zu < %zu\n", ws_size, (size_t)WS_TOTAL); return; }
    (void)hipMemsetAsync((unsigned char*)d_ws + WS_BAR, 0, 16384, stream);
    Params p{};
    for (int i = 0; i < 17; ++i) p.in[i] = (const float*)d_in[i];
#ifdef DBG_K
    p.out = (float*)d_out; p.ws = (unsigned char*)d_ws; p.ph_lo = 0; p.ph_hi = DBG_K;
#else
    p.out = (float*)d_out; p.ws = (unsigned char*)d_ws; p.ph_lo = 0; p.ph_hi = 13;
#endif
    void* args[] = {&p};
    hipError_t e = hipLaunchCooperativeKernel((const void*)mega, dim3(grid_blocks), dim3(512), args, LDS_BYTES, stream);
    if (e != hipSuccess) fprintf(stderr, "cooperative launch failed: %s (grid %d)\n", hipGetErrorString(e), grid_blocks);
}
```
